# Optimizing an MI355X kernel written in HIP

```python
import math
import jax, jax.numpy as jnp
from jax import lax
import numpy as np

D_MODEL = 1024
BATCH = 8
SEQ = 2048
DEPTH = 4

HD = 64
N_HEADS = D_MODEL // HD
N_KV = 4
Q_PER_KV = N_HEADS // N_KV
D_A = D_MODEL
D_B = N_HEADS * HD
D_C = D_MODEL
SGU_GROUPS = 8
CHUNK = 128
CONV_W = 3
CMP_LEN = 32
CMP_STRIDE = 16
CMP_HID = 2 * HD
SEL_BLOCK = 64
SEL_TOP_N = 8
WINDOW = 512
Q_BLOCK = 128
D_FF = 3 * D_MODEL
N_BUCKETS = 32
MAX_EXACT = N_BUCKETS // 2
REL_MAX_DIST = 128
N_IN = 3 * D_A + D_B + 6 * N_KV * HD + 3 * N_HEADS + 2 * D_C + 3 * D_MODEL
SCALE = HD ** -0.5
EPS = 1e-6
NEG_INF = -1e30
FORCE = 1e9

kernel_name = 'hybrid_conv_nsa_sgu_block'


def rms_norm(x, g):
    x32 = x.astype(jnp.float32)
    y = x32 * lax.rsqrt(jnp.mean(x32 * x32, axis=-1, keepdims=True) + EPS)
    return (y * g.astype(jnp.float32)).astype(x.dtype)


def layer_norm(x, g, b):
    x32 = x.astype(jnp.float32)
    mu = jnp.mean(x32, axis=-1, keepdims=True)
    var = jnp.mean(jnp.square(x32 - mu), axis=-1, keepdims=True)
    y = (x32 - mu) * lax.rsqrt(var + EPS)
    return (y * g.astype(jnp.float32) + b.astype(jnp.float32)).astype(x.dtype)


def causal_dwconv3(x, w):
    s = x.shape[1]
    xp = jnp.pad(x, ((0, 0), (CONV_W - 1, 0), (0, 0)))
    return sum(w[k] * xp[:, k:k + s] for k in range(CONV_W))


def masked_softmax(logits, mask):
    lg = jnp.where(mask, logits, NEG_INF)
    return jnp.where(mask, jax.nn.softmax(lg, axis=-1), 0.0)


def rel_bucket(dist):
    dist = jnp.maximum(dist, 0)
    log_ratio = jnp.log(jnp.maximum(dist, 1).astype(jnp.float32) / MAX_EXACT) / math.log(REL_MAX_DIST / MAX_EXACT)
    large = MAX_EXACT + (log_ratio * (N_BUCKETS - MAX_EXACT)).astype(jnp.int32)
    return jnp.where(dist < MAX_EXACT, dist, jnp.minimum(large, N_BUCKETS - 1))


def compress_blocks(k, pos_emb, w1, w2):
    b_, g_, s_, _ = k.shape
    n_cmp = (s_ - CMP_LEN) // CMP_STRIDE + 1
    idx = CMP_STRIDE * jnp.arange(n_cmp)[:, None] + jnp.arange(CMP_LEN)[None]
    blocks = (k[:, :, idx] + pos_emb).reshape(b_, g_, n_cmp, CMP_LEN * HD)
    return jax.nn.gelu(blocks @ w1) @ w2


def nsa_mixer(q, kc, vc, ks, vs, kw, vw, gates, rel_bias, cmp_pos, cmp_w1, cmp_w2):
    b_, s_ = q.shape[0], q.shape[1]
    n_qb = s_ // Q_BLOCK
    q = q.reshape(b_, s_, N_KV, Q_PER_KV, HD).transpose(0, 2, 3, 1, 4)
    kc, vc, ks, vs, kw, vw = [a.transpose(0, 2, 1, 3) for a in (kc, vc, ks, vs, kw, vw)]
    k_cmp = compress_blocks(kc, cmp_pos[0], cmp_w1[0], cmp_w2[0])
    v_cmp = compress_blocks(vc, cmp_pos[1], cmp_w1[1], cmp_w2[1])
    n_cmp = k_cmp.shape[2]
    cmp_start = jnp.arange(n_cmp) * CMP_STRIDE
    cmp_end = cmp_start + CMP_LEN - 1
    n_blk = s_ // SEL_BLOCK
    n_sel = min(SEL_TOP_N, n_blk)
    blk_start = jnp.arange(n_blk) * SEL_BLOCK
    overlap = ((cmp_start[:, None] < blk_start[None] + SEL_BLOCK)
               & (cmp_end[:, None] >= blk_start[None])).astype(jnp.float32)
    k_blk = ks.reshape(b_, N_KV, n_blk, SEL_BLOCK, HD)
    v_blk = vs.reshape(b_, N_KV, n_blk, SEL_BLOCK, HD)
    kw_pad = jnp.pad(kw, ((0, 0), (0, 0), (WINDOW, 0), (0, 0)))
    vw_pad = jnp.pad(vw, ((0, 0), (0, 0), (WINDOW, 0), (0, 0)))
    table = rel_bias.astype(jnp.float32)
    table_g = table.reshape(N_BUCKETS, N_KV, Q_PER_KV).transpose(1, 0, 2)
    bi = jnp.arange(b_)[:, None, None, None]
    gi = jnp.arange(N_KV)[None, :, None, None]

    def static_bias(dist):
        return table[rel_bucket(dist)].reshape(dist.shape + (N_KV, Q_PER_KV)).transpose(2, 3, 0, 1)

    def block(args):
        qb, gb, i = args
        t0 = i * Q_BLOCK
        t = t0 + jnp.arange(Q_BLOCK)
        d_c = t[:, None] - cmp_end[None]
        ok_c = d_c >= 0
        lg = jnp.einsum('bgrqd,bgnd->bgrqn', qb, k_cmp).astype(jnp.float32) * SCALE + static_bias(d_c)
        p_c = masked_softmax(lg, ok_c)
        o_c = jnp.einsum('bgrqn,bgnd->bgrqd', p_c.astype(v_cmp.dtype), v_cmp)
        imp = jnp.einsum('bgrqn,nj->bgqj', p_c, overlap)
        cur = t // SEL_BLOCK
        j = jnp.arange(n_blk)
        forced = (j[None] == 0) | (j[None] == cur[:, None]) | (j[None] == cur[:, None] - 1)
        valid = blk_start[None] <= t[:, None]
        score = jnp.where(forced, FORCE, jnp.where(valid, imp, -FORCE))
        top_s, idx = lax.top_k(score, n_sel)
        n_key = n_sel * SEL_BLOCK
        k_g = k_blk[bi, gi, idx].reshape(b_, N_KV, Q_BLOCK, n_key, HD)
        v_g = v_blk[bi, gi, idx].reshape(b_, N_KV, Q_BLOCK, n_key, HD)
        pos = (idx[..., None] * SEL_BLOCK + jnp.arange(SEL_BLOCK)).reshape(b_, N_KV, Q_BLOCK, n_key)
        d_s = t[:, None] - pos
        ok_s = jnp.repeat(top_s >= 0, SEL_BLOCK, axis=-1) & (d_s >= 0)
        bias_s = jnp.moveaxis(table_g[gi, rel_bucket(d_s)], -1, 2)
        lg = jnp.einsum('bgrqd,bgqkd->bgrqk', qb, k_g).astype(jnp.float32) * SCALE + bias_s
        p_s = masked_softmax(lg, ok_s[:, :, None])
        o_s = jnp.einsum('bgrqk,bgqkd->bgrqd', p_s.astype(v_g.dtype), v_g)
        kwb = lax.dynamic_slice_in_dim(kw_pad, t0, WINDOW + Q_BLOCK, axis=2)
        vwb = lax.dynamic_slice_in_dim(vw_pad, t0, WINDOW + Q_BLOCK, axis=2)
        s_pos = t0 - WINDOW + jnp.arange(WINDOW + Q_BLOCK)
        d_w = t[:, None] - s_pos[None]
        ok_w = (d_w >= 0) & (d_w < WINDOW) & (s_pos[None] >= 0)
        lg = jnp.einsum('bgrqd,bgkd->bgrqk', qb, kwb).astype(jnp.float32) * SCALE + static_bias(d_w)
        p_w = masked_softmax(lg, ok_w)
        o_w = jnp.einsum('bgrqk,bgkd->bgrqd', p_w.astype(vwb.dtype), vwb)
        g = gb.reshape(b_, Q_BLOCK, 3, N_KV, Q_PER_KV).transpose(2, 0, 3, 4, 1)[..., None]
        return g[0] * o_c + g[1] * o_s + g[2] * o_w

    q_blocks = q.reshape(b_, N_KV, Q_PER_KV, n_qb, Q_BLOCK, HD).transpose(3, 0, 1, 2, 4, 5)
    g_blocks = gates.reshape(b_, n_qb, Q_BLOCK, 3, N_HEADS).transpose(1, 0, 2, 3, 4)
    out = lax.map(block, (q_blocks, g_blocks, jnp.arange(n_qb)))
    return out.transpose(1, 0, 4, 2, 3, 5).reshape(b_, s_, D_B)


def spatial_gating(u, v, w_s, b_s, g, bn):
    b_, s_, _ = v.shape
    v = layer_norm(v, g, bn).reshape(b_, s_ // CHUNK, CHUNK, SGU_GROUPS, D_C // SGU_GROUPS)
    w = jnp.where(jnp.tril(jnp.ones((CHUNK, CHUNK), dtype=bool)), w_s, 0)
    mixed = jnp.einsum('gts,bcsgk->bctgk', w, v) + b_s.T[:, :, None]
    return u * mixed.reshape(b_, s_, D_C)


def hybrid_mixer(h, rel_bias, w_in, conv_a, cmp_pos, cmp_w1, cmp_w2, sgu_w, sgu_b,
                 sgu_norm_g, sgu_norm_b, w_br_a, w_br_b, w_br_c, w_o):
    b_, s_, _ = h.shape
    proj = h @ w_in
    sizes = [D_A, D_A, D_A, D_B] + [N_KV * HD] * 6 + [3 * N_HEADS, D_C, D_C, D_MODEL, D_MODEL, D_MODEL]
    splits, acc = [], 0
    for sz in sizes[:-1]:
        acc += sz
        splits.append(acc)
    (gate_b, gate_c, val_a, q, kc, vc, ks, vs, kw, vw, g_nsa,
     u_c, v_c, g0, g1, g2) = jnp.split(proj, splits, axis=-1)
    out_a = gate_b * causal_dwconv3(gate_c * val_a, conv_a)
    kv = [a.reshape(b_, s_, N_KV, HD) for a in (kc, vc, ks, vs, kw, vw)]
    out_b = nsa_mixer(q.reshape(b_, s_, N_HEADS, HD), *kv,
                      jax.nn.sigmoid(g_nsa).reshape(b_, s_, 3, N_HEADS),
                      rel_bias, cmp_pos, cmp_w1, cmp_w2)
    out_c = spatial_gating(jax.nn.gelu(u_c), jax.nn.gelu(v_c), sgu_w, sgu_b, sgu_norm_g, sgu_norm_b)
    merged = (jax.nn.sigmoid(g0) * (out_a @ w_br_a)
              + jax.nn.sigmoid(g1) * (out_b @ w_br_b)
              + jax.nn.sigmoid(g2) * (out_c @ w_br_c))
    return merged @ w_o


def conv_ffn(h, w_up, conv_w, w_down):
    gate, val = jnp.split(h @ w_up, 2, axis=-1)
    return (jax.nn.gelu(causal_dwconv3(gate, conv_w)) * val) @ w_down


def setup_inputs(seed: int = 0) -> dict:
    key = jax.random.key(seed)
    ks = jax.random.split(key, 22)
    nrm = lambda k, shape, scale: scale * jax.random.normal(k, shape, jnp.float32)
    L = DEPTH
    return {
        'x': nrm(ks[0], (BATCH, SEQ, D_MODEL), 1.0),
        'rel_bias': nrm(ks[1], (N_BUCKETS, N_HEADS), 0.1),
        'norm_mix': 1.0 + nrm(ks[2], (L, D_MODEL), 0.01),
        'w_in': nrm(ks[3], (L, D_MODEL, N_IN), D_MODEL ** -0.5),
        'conv_a': nrm(ks[4], (L, CONV_W, D_A), CONV_W ** -0.5),
        'cmp_pos': nrm(ks[5], (L, 2, CMP_LEN, HD), 0.1),
        'cmp_w1': nrm(ks[6], (L, 2, CMP_LEN * HD, CMP_HID), (CMP_LEN * HD) ** -0.5),
        'cmp_w2': nrm(ks[7], (L, 2, CMP_HID, HD), CMP_HID ** -0.5),
        'sgu_w': nrm(ks[8], (L, SGU_GROUPS, CHUNK, CHUNK), CHUNK ** -0.5),
        'sgu_b': 1.0 + nrm(ks[9], (L, SGU_GROUPS, CHUNK), 0.01),
        'sgu_norm_g': 1.0 + nrm(ks[10], (L, D_C), 0.01),
        'sgu_norm_b': nrm(ks[11], (L, D_C), 0.01),
        'w_br_a': nrm(ks[12], (L, D_A, D_MODEL), D_A ** -0.5),
        'w_br_b': nrm(ks[13], (L, D_B, D_MODEL), D_B ** -0.5),
        'w_br_c': nrm(ks[14], (L, D_C, D_MODEL), D_C ** -0.5),
        'w_o': nrm(ks[15], (L, D_MODEL, D_MODEL), D_MODEL ** -0.5),
        'norm_ffn': 1.0 + nrm(ks[16], (L, D_MODEL), 0.01),
        'ffn_w_up': nrm(ks[17], (L, D_MODEL, 2 * D_FF), D_MODEL ** -0.5),
        'ffn_conv': nrm(ks[18], (L, CONV_W, D_FF), CONV_W ** -0.5),
        'ffn_w_down': nrm(ks[19], (L, D_FF, D_MODEL), D_FF ** -0.5),
        'norm_final': 1.0 + nrm(ks[20], (D_MODEL,), 0.01),
    }


def reference(x, rel_bias, norm_mix, w_in, conv_a, cmp_pos, cmp_w1, cmp_w2, sgu_w, sgu_b,
              sgu_norm_g, sgu_norm_b, w_br_a, w_br_b, w_br_c, w_o, norm_ffn, ffn_w_up,
              ffn_conv, ffn_w_down, norm_final):
    for l in range(DEPTH):
        h = rms_norm(x, norm_mix[l])
        x = x + hybrid_mixer(h, rel_bias, w_in[l], conv_a[l], cmp_pos[l], cmp_w1[l], cmp_w2[l],
                             sgu_w[l], sgu_b[l], sgu_norm_g[l], sgu_norm_b[l],
                             w_br_a[l], w_br_b[l], w_br_c[l], w_o[l])
        h = rms_norm(x, norm_ffn[l])
        x = x + conv_ffn(h, ffn_w_up[l], ffn_conv[l], ffn_w_down[l])
    return rms_norm(x, norm_final)
```

```cpp
#include <hip/hip_runtime.h>
#include <hip/hip_cooperative_groups.h>
#include <cstdio>
namespace cg = cooperative_groups;

#ifndef PHASE_MASK
#define PHASE_MASK 0x1fff
#endif
#define PHON(k) ((PHASE_MASK >> (k)) & 1)
#ifndef PER_PHASE_LAUNCH
#define PER_PHASE_LAUNCH 0
#endif

#define LAS __attribute__((address_space(3)))
#define DEV __device__ __forceinline__
#define OPQV(x) asm volatile("" : "+v"(x))
#define OPQS(x) asm volatile("" : "+s"(x))
typedef unsigned short bf16_t;
typedef short bf16x8 __attribute__((ext_vector_type(8)));
typedef float f32x4 __attribute__((ext_vector_type(4)));
typedef unsigned u32x4 __attribute__((ext_vector_type(4)));
typedef unsigned u32x2 __attribute__((ext_vector_type(2)));

constexpr int T_ = 16384, S_ = 2048, NP = 11008, NIN = 10800, DFF = 3072;
constexpr int COL_GB = 0, COL_GC = 1024, COL_VA = 2048, COL_Q = 3072, COL_KC = 4096, COL_VC = 4352, COL_KS = 4608, COL_VS = 4864,
              COL_KW = 5120, COL_VW = 5376, COL_U = 5632, COL_V = 6656, COL_G0 = 7680, COL_GN = 10752;
constexpr float EPS_ = 1e-6f, SCALE_ = 0.125f, NEG_ = -1e30f, LOG2E_ = 1.4426950408889634f, QSC_ = 0.125f * 1.4426950408889634f;
constexpr int LDS_EX = 131072 + 16;
constexpr int LDS_BYTES = 131072 + 16 + 1024;
constexpr int NPHASE = 41;

constexpr size_t WS_WIN = 0;
constexpr size_t WS_WBR = WS_WIN + (size_t)NP * 1024 * 2;
constexpr size_t WS_WO = WS_WBR + (size_t)3072 * 1024 * 2;
constexpr size_t WS_WUP = WS_WO + (size_t)1024 * 1024 * 2;
constexpr size_t WS_WDN = WS_WUP + (size_t)6144 * 1024 * 2;
constexpr size_t WS_W1T = WS_WDN + (size_t)1024 * 3072 * 2;
constexpr size_t WS_W2T = WS_W1T + (size_t)2 * 128 * 2048 * 2;
constexpr size_t WS_KC = WS_W2T + (size_t)2 * 64 * 128 * 2;
constexpr size_t WS_VC = WS_KC + (size_t)32 * 128 * 64 * 2;
constexpr size_t WS_H = WS_VC + (size_t)32 * 128 * 64 * 2;
constexpr size_t WS_P = WS_H + (size_t)T_ * 1024 * 2;
constexpr size_t WS_O3 = WS_P + (size_t)T_ * NP * 2;
constexpr size_t WS_MF = WS_O3 + (size_t)3 * T_ * 1024 * 2;
constexpr size_t WS_KV = WS_MF + 4096;
constexpr size_t WS_X = WS_MF + (size_t)T_ * 1024 * 4;
constexpr size_t WS_QB = WS_X + (size_t)T_ * 1024 * 2;
constexpr size_t WS_GLA = WS_QB + (size_t)T_ * 1024 * 2;
constexpr size_t WS_GFA = WS_GLA + (size_t)64 * 2 * 1024 * 4;
constexpr size_t WS_END = WS_GFA + (size_t)64 * 2 * 2 * 1024 * 4;
constexpr size_t WS_BAR = WS_MF + (size_t)60 * 1048576;
constexpr size_t WS_GL = WS_MF + (size_t)52 * 1048576;
constexpr size_t WS_GF = WS_GL + (size_t)64 * 2 * DFF * 4;
constexpr size_t KV_TENSOR = (size_t)8 * 4 * S_ * 64;

struct Params { const float* in[21]; float* out; unsigned char* ws; int ph_lo, ph_hi; };

DEV float bf2f(unsigned b) { return __uint_as_float(b << 16); }
DEV float bflo(unsigned u) { return __uint_as_float(u << 16); }
DEV float bfhi(unsigned u) { return __uint_as_float(u & 0xffff0000u); }
DEV unsigned cvt_pk_bf16(float lo, float hi) { unsigned r; asm volatile("v_cvt_pk_bf16_f32 %0, %1, %2" : "=v"(r) : "v"(lo), "v"(hi)); return r; }
DEV float gelu_t(float x) { const float u = x * (0.7978845608f + 0.0356774081f * x * x); return x * __builtin_amdgcn_rcpf(1.f + __builtin_amdgcn_exp2f(-2.885390082f * u)); }
DEV float sigm(float x) { return __builtin_amdgcn_rcpf(1.f + __builtin_amdgcn_exp2f(-1.4426950409f * x)); }
DEV void unpack8(const u32x4 v, float (&f)[8]) { f[0] = bflo(v.x); f[1] = bfhi(v.x); f[2] = bflo(v.y); f[3] = bfhi(v.y); f[4] = bflo(v.z); f[5] = bfhi(v.z); f[6] = bflo(v.w); f[7] = bfhi(v.w); }
DEV u32x4 pack8(const float (&f)[8]) { u32x4 w; w.x = cvt_pk_bf16(f[0], f[1]); w.y = cvt_pk_bf16(f[2], f[3]); w.z = cvt_pk_bf16(f[4], f[5]); w.w = cvt_pk_bf16(f[6], f[7]); return w; }
DEV u32x4 pair32(u32x2 a, u32x2 b) {
    const auto r0 = __builtin_amdgcn_permlane32_swap(a.x, b.x, false, false); const auto r1 = __builtin_amdgcn_permlane32_swap(a.y, b.y, false, false);
    return (u32x4){r0[0], r1[0], r0[1], r1[1]};
}
DEV bf16x8 as_bf16x8(u32x4 v) { union { u32x4 u; bf16x8 b; } x; x.u = v; return x.b; }

namespace pg8 {
constexpr int BM = 256, BK = 64, HALF = 128, HTB = HALF * BK * 2, NXCD = 8, WGM = 8;
DEV int lds_byte(int r, int c) { const int st = (r >> 4) * 2 + (c >> 5), rr = r & 15, cc = c & 31, ob = rr * 64 + cc * 2; return st * 1024 + (ob ^ (((ob >> 9) & 1) << 5)); }
DEV void stage_rc(int b, int& R, int& C) { const int st = b / 1024, sb = b % 1024, swz = sb ^ (((sb >> 9) & 1) << 5); R = (st >> 1) * 16 + swz / 64; C = (st & 1) * 32 + (swz % 64) / 2; }
DEV int perm32(int rho) { const int n = rho >> 4, i = rho & 15; return 8 * (i >> 2) + 4 * n + (i & 3); }
struct Unit { int pm, pn; };
struct Gemm { const bf16_t* A; const bf16_t* Bt; int M, N, K; };

struct StaticOrder {
    int nM, nN, nwg, G, c;
    DEV void init(int M, int N, int G_, int c_) { nM = M / BM; nN = N / BM; nwg = nM * nN; G = G_; c = c_; }
    DEV bool tile(long L, Unit& u) const {
        if (L >= nwg) return false;
        int wgid = (int)L; { const int q = nwg / NXCD, r = nwg % NXCD, xcd = wgid % NXCD, off = wgid / NXCD; wgid = (xcd < r ? xcd * (q + 1) : r * (q + 1) + (xcd - r) * q) + off; }
        const int nig = WGM * nN, gid = wgid / nig, fm = gid * WGM, gsz = (nM - fm) < WGM ? (nM - fm) : WGM;
        u.pm = fm + ((wgid % nig) % gsz); u.pn = (wgid % nig) / gsz; return true;
    }
    DEV bool next(int i, Unit& u) const { return tile((long)i * G + c, u); }
};
struct BranchOrder {
    StaticOrder so;
    DEV void init(int G_, int c_) { so.init(T_, 1024, G_, c_); }
    DEV bool next(int i, Unit& u) const { const int round = i / 3, br = i - round * 3; Unit t; if (!so.tile((long)round * so.G + so.c, t)) return false; u.pm = br * 64 + t.pm; u.pn = br * 4 + t.pn; return true; }
};

struct EpiProj {
    static constexpr bool PERM = true, ROWPERM = true;
    bf16_t* O; int ldc; int act_mode; bf16_t* KV; bf16_t* OA; bf16_t* QB; const float* cwa; float* GLA; float* GFA; LAS unsigned char* ex;
    DEV bool operator()(f32x4 (&acc)[2][2][4][2], const Unit& u, int wr, int wc, int fr, int fq) const {
        const int row0 = u.pm * BM + (16 * wr + fr) * 8, col0 = u.pn * BM + wc * 32 + 8 * fq;
        const int act = act_mode ? 0 : (u.pn < 22 ? 0 : (u.pn < 26 ? 1 : 2));
        const bool kvt = !act_mode && u.pn >= 16 && u.pn < 22;
        if (!act_mode && u.pn >= 26 && u.pn < 42) {
            const int chb = (u.pn - 26) * 64 + wc * 16 + (fq & 1) * 8, up = fq >> 1;
#pragma unroll
            for (int ai = 0; ai < 2; ++ai)
#pragma unroll
                for (int mp = 0; mp < 2; ++mp) { u32x2 pk[2][4];
#pragma unroll
                    for (int mm = 0; mm < 2; ++mm) { const int m = mp * 2 + mm; float f0[4], f1[4], f2[4], uu[4];
#pragma unroll
                        for (int j = 0; j < 4; ++j) { const float s0 = sigm(acc[ai][0][m][0][j]), s1 = fmaxf(sigm(acc[ai][0][m][1][j]), 1e-12f), s2 = fmaxf(sigm(acc[ai][1][m][0][j]), 1e-12f);
                            f0[j] = s0 * __builtin_amdgcn_rcpf(s1); f1[j] = s1 * __builtin_amdgcn_rcpf(s2); f2[j] = s2; uu[j] = gelu_t(acc[ai][1][m][1][j]); }
                        pk[mm][0].x = cvt_pk_bf16(f0[0], f0[1]); pk[mm][0].y = cvt_pk_bf16(f0[2], f0[3]); pk[mm][1].x = cvt_pk_bf16(f1[0], f1[1]); pk[mm][1].y = cvt_pk_bf16(f1[2], f1[3]);
                        pk[mm][2].x = cvt_pk_bf16(f2[0], f2[1]); pk[mm][2].y = cvt_pk_bf16(f2[2], f2[3]); pk[mm][3].x = cvt_pk_bf16(uu[0], uu[1]); pk[mm][3].y = cvt_pk_bf16(uu[2], uu[3]); }
                    bf16_t* rp = O + (size_t)(row0 + ai * 4 + mp * 2 + up) * ldc + chb;
                    *(u32x4*)(rp + COL_G0) = pair32(pk[0][0], pk[1][0]);
                    *(u32x4*)(rp + COL_G0 + 1024) = pair32(pk[0][1], pk[1][1]);
                    *(u32x4*)(rp + COL_G0 + 2048) = pair32(pk[0][2], pk[1][2]);
                    *(u32x4*)(rp + COL_U) = pair32(pk[0][3], pk[1][3]); }
            return true;
        }
        if (!act_mode && u.pn < 16) {
            const int ch0 = u.pn * 64 + wc * 16 + (fq & 1) * 8 + (fq >> 1) * 4, chb = u.pn * 64 + wc * 16 + (fq & 1) * 8, up = fq >> 1;
            f32x4 w[3];
#pragma unroll
            for (int k = 0; k < 3; ++k) w[k] = *(const f32x4*)(cwa + k * 1024 + ch0);
            f32x4 xp[8];
#pragma unroll
            for (int i = 0; i < 8; ++i) xp[i] = acc[i >> 2][0][i & 3][1] * acc[i >> 2][1][i & 3][0];
            f32x4 p6, p7;
#pragma unroll
            for (int c = 0; c < 4; ++c) { p6[c] = __shfl_up(xp[6][c], 1); p7[c] = __shfl_up(xp[7][c], 1); }
            LAS f32x4* EX = (LAS f32x4*)ex + (wc * 4 + fq) * 2;
            if (wr == 0 && fr == 15) { EX[0] = xp[6]; EX[1] = xp[7]; asm volatile("s_waitcnt lgkmcnt(0)" ::: "memory"); }
            if (wr == 1 && fr == 0) { p6 = EX[0]; p7 = EX[1]; }
            if (wr == 1 && fr == 15) { float* gl = GLA + (size_t)u.pm * 2 * 1024 + ch0; *(f32x4*)gl = xp[6]; *(f32x4*)(gl + 1024) = xp[7]; }
            const bool halo = (wr == 0 && fr == 0);
            if (halo) {
#pragma unroll
                for (int t = 0; t < 2; ++t) { float* gf = GFA + ((size_t)(u.pm * 2 + t) * 2) * 1024 + ch0; *(f32x4*)gf = acc[0][0][t][0]; *(f32x4*)(gf + 1024) = xp[t]; } }
#pragma unroll
            for (int ip = 0; ip < 4; ++ip) { u32x2 o[2], q2[2];
#pragma unroll
                for (int ii = 0; ii < 2; ++ii) { const int i = ip * 2 + ii;
                    const f32x4 xm1 = i >= 1 ? xp[i >= 1 ? i - 1 : 0] : p7, xm2 = i >= 2 ? xp[i >= 2 ? i - 2 : 0] : (i == 0 ? p6 : p7);
                    const f32x4 y = acc[i >> 2][0][i & 3][0] * (w[0] * xm2 + w[1] * xm1 + w[2] * xp[i]);
                    o[ii].x = cvt_pk_bf16(y[0], y[1]); o[ii].y = cvt_pk_bf16(y[2], y[3]);
                    const f32x4 qv = acc[i >> 2][1][i & 3][1];
                    q2[ii].x = cvt_pk_bf16(qv[0], qv[1]); q2[ii].y = cvt_pk_bf16(qv[2], qv[3]); }
                const size_t tok = (size_t)(row0 + ip * 2 + up);
                const u32x4 ow = pair32(o[0], o[1]), qw = pair32(q2[0], q2[1]);
                if (!(halo && ip == 0)) *(u32x4*)(OA + tok * 1024 + chb) = ow;
                *(u32x4*)(QB + tok * 1024 + chb) = qw; }
            return true;
        }
#pragma unroll
        for (int ai = 0; ai < 2; ++ai)
#pragma unroll
            for (int m = 0; m < 4; ++m) { const int row = row0 + ai * 4 + m; bf16_t* rowp = O + (size_t)row * ldc + col0 + ((!act_mode && u.pn >= 22 && u.pn < 26) ? 1024 : 0);
                if (kvt) rowp = KV + (size_t)(u.pn - 16) * KV_TENSOR + ((size_t)((row >> 11) * 4) * S_ + (row & (S_ - 1))) * 64 + (size_t)(wc >> 1) * S_ * 64 + (wc & 1) * 32 + 8 * fq;
#pragma unroll
                for (int bj = 0; bj < 2; ++bj) { float v[8];
#pragma unroll
                    for (int j = 0; j < 4; ++j) { v[j] = acc[ai][bj][m][0][j]; v[4 + j] = acc[ai][bj][m][1][j]; }
                    if (act == 1) {
#pragma unroll
                        for (int j = 0; j < 8; ++j) v[j] = gelu_t(v[j]); }
                    else if (act == 2) {
#pragma unroll
                        for (int j = 0; j < 8; ++j) v[j] = sigm(v[j]); }
                    *(u32x4*)(rowp + (kvt ? (size_t)bj * 2 * S_ * 64 : (size_t)bj * HALF)) = pack8(v); } }
        return true;
    }
};
struct EpiBranch {
    static constexpr bool PERM = true, ROWPERM = false;
    const bf16_t* P; bf16_t* MB;
    DEV bool operator()(f32x4 (&acc)[2][2][4][2], const Unit& u, int wr, int wc, int fr, int fq) const {
        const int br = u.pn >> 2, pn = u.pn & 3, pm = u.pm - br * 64;
        const int row0 = pm * BM + wr * 64 + fr, col0 = pn * BM + wc * 32 + 8 * fq;
#pragma unroll
        for (int ai = 0; ai < 2; ++ai) {
            u32x4 ga[4][2];
#pragma unroll
            for (int m = 0; m < 4; ++m)
#pragma unroll
                for (int bj = 0; bj < 2; ++bj) ga[m][bj] = *(const u32x4*)(P + (size_t)(row0 + ai * HALF + m * 16) * NP + COL_G0 + br * 1024 + col0 + bj * HALF);
#pragma unroll
            for (int m = 0; m < 4; ++m)
#pragma unroll
                for (int bj = 0; bj < 2; ++bj) { const size_t row = (size_t)(row0 + ai * HALF + m * 16);
                    float f[8], v[8]; unpack8(ga[m][bj], f);
#pragma unroll
                    for (int j = 0; j < 4; ++j) { v[j] = acc[ai][bj][m][0][j] * f[j]; v[4 + j] = acc[ai][bj][m][1][j] * f[4 + j]; }
                    if (br < 2) { acc[ai][bj][m][0] = (f32x4){v[0], v[1], v[2], v[3]}; acc[ai][bj][m][1] = (f32x4){v[4], v[5], v[6], v[7]}; }
                    else *(u32x4*)(MB + row * 1024 + col0 + bj * HALF) = pack8(v); }
        }
        return br == 2;
    }
};
struct EpiRes {
    static constexpr bool PERM = true, ROWPERM = false;
    bf16_t* X;
    DEV bool operator()(f32x4 (&acc)[2][2][4][2], const Unit& u, int wr, int wc, int fr, int fq) const {
        const int row0 = u.pm * BM + wr * 64 + fr, col0 = u.pn * BM + wc * 32 + 8 * fq;
#pragma unroll
        for (int ai = 0; ai < 2; ++ai) {
            u32x4 old[4][2];
#pragma unroll
            for (int m = 0; m < 4; ++m)
#pragma unroll
                for (int bj = 0; bj < 2; ++bj) old[m][bj] = *(const u32x4*)(X + (size_t)(row0 + ai * HALF + m * 16) * 1024 + col0 + bj * HALF);
#pragma unroll
            for (int m = 0; m < 4; ++m)
#pragma unroll
                for (int bj = 0; bj < 2; ++bj) { float v[8]; unpack8(old[m][bj], v);
#pragma unroll
                    for (int j = 0; j < 4; ++j) { v[j] += acc[ai][bj][m][0][j]; v[4 + j] += acc[ai][bj][m][1][j]; }
                    *(u32x4*)(X + (size_t)(row0 + ai * HALF + m * 16) * 1024 + col0 + bj * HALF) = pack8(v); }
        }
        return true;
    }
};
struct EpiAct {
    static constexpr bool PERM = true, ROWPERM = true;
    bf16_t* ACT; const float* cw; float* GL; float* GF; LAS unsigned char* ex;
    DEV bool operator()(f32x4 (&acc)[2][2][4][2], const Unit& u, int wr, int wc, int fr, int fq) const {
        const int ch0 = u.pn * 128 + wc * 32 + 8 * fq;
        float w[3][8];
#pragma unroll
        for (int k = 0; k < 3; ++k) { const f32x4 w0 = *(const f32x4*)(cw + k * DFF + ch0), w1 = *(const f32x4*)(cw + k * DFF + ch0 + 4);
#pragma unroll
            for (int j = 0; j < 4; ++j) { w[k][j] = w0[j]; w[k][4 + j] = w1[j]; } }
        float p6[8], p7[8];
#pragma unroll
        for (int c = 0; c < 8; ++c) { p6[c] = __shfl_up(acc[1][0][2][c >> 2][c & 3], 1); p7[c] = __shfl_up(acc[1][0][3][c >> 2][c & 3], 1); }
        LAS float* EX = (LAS float*)ex + (wc * 4 + fq) * 16;
        if (wr == 0 && fr == 15) {
#pragma unroll
            for (int c = 0; c < 8; ++c) { EX[c] = acc[1][0][2][c >> 2][c & 3]; EX[8 + c] = acc[1][0][3][c >> 2][c & 3]; }
            asm volatile("s_waitcnt lgkmcnt(0)" ::: "memory");
        }
        if (wr == 1 && fr == 0) {
#pragma unroll
            for (int c = 0; c < 8; ++c) { p6[c] = EX[c]; p7[c] = EX[8 + c]; } }
        if (wr == 1 && fr == 15) { float* gl = GL + (size_t)u.pm * 2 * DFF + ch0;
            *(f32x4*)gl = acc[1][0][2][0]; *(f32x4*)(gl + 4) = acc[1][0][2][1]; *(f32x4*)(gl + DFF) = acc[1][0][3][0]; *(f32x4*)(gl + DFF + 4) = acc[1][0][3][1]; }
        const bool halo = (wr == 0 && fr == 0);
        if (halo) {
#pragma unroll
            for (int t = 0; t < 2; ++t) { float* gf = GF + ((size_t)(u.pm * 2 + t) * 2) * DFF + ch0;
                *(f32x4*)gf = acc[0][0][t][0]; *(f32x4*)(gf + 4) = acc[0][0][t][1]; *(f32x4*)(gf + DFF) = acc[0][1][t][0]; *(f32x4*)(gf + DFF + 4) = acc[0][1][t][1]; } }
        bf16_t* outp = ACT + ((size_t)u.pm * BM + (size_t)(16 * wr + fr) * 8) * DFF + ch0;
#pragma unroll
        for (int i = 0; i < 8; ++i) { float y[8];
#pragma unroll
            for (int c = 0; c < 8; ++c) {
                const float g0 = acc[i >> 2][0][i & 3][c >> 2][c & 3];
                const float gm1 = i >= 1 ? acc[(i - 1 < 0 ? 0 : i - 1) >> 2][0][(i - 1 < 0 ? 0 : i - 1) & 3][c >> 2][c & 3] : p7[c];
                const float gm2 = i >= 2 ? acc[(i - 2 < 0 ? 0 : i - 2) >> 2][0][(i - 2 < 0 ? 0 : i - 2) & 3][c >> 2][c & 3] : (i == 0 ? p6[c] : p7[c]);
                y[c] = gelu_t(w[0][c] * gm2 + w[1][c] * gm1 + w[2][c] * g0) * acc[i >> 2][1][i & 3][c >> 2][c & 3]; }
            if (!(halo && i < 2)) *(u32x4*)(outp + (size_t)i * DFF) = pack8(y); }
        return true;
    }
};

template <class Epi, class Sched>
DEV void gemm_phase(LAS unsigned char* lds, const Gemm g, const Sched& S, const Epi& E) {
    int tid = threadIdx.x; OPQV(tid);
    const int wid = __builtin_amdgcn_readfirstlane(tid >> 6), lane = tid & 63, wr = wid >> 2, wc = wid & 3, fr = lane & 15, fq = lane >> 4;
    const int K = g.K, nt = K / BK;
    unsigned voffA[2], voffB[2];
#pragma unroll
    for (int i = 0; i < 2; ++i) { int R, C; stage_rc(tid * 16 + i * 8192, R, C); const int Rb = Epi::PERM ? ((R & ~31) + perm32(R & 31)) : R;
        const int Ra = Epi::ROWPERM ? (((R >> 6) * 16 + (R & 15)) * 8 + ((R >> 4) & 3)) : R;
        voffA[i] = (unsigned)(Ra * K + C) * 2u; voffB[i] = (unsigned)(Rb * K + C) * 2u; }
    const size_t kstep = (size_t)(BK * 2);
    const size_t hstep = (size_t)HALF * K * 2;
    const size_t hstepA = Epi::ROWPERM ? (size_t)4 * K * 2 : hstep;
    const size_t tstep = 2 * hstep;
    const unsigned ldsw = (unsigned)wid * 1024u;
    const int aoff = lds_byte(wr * 64 + fr, fq * 8), boff = lds_byte(wc * 32 + fr, fq * 8);
#define PG8_SA(b, h) (((b) * 2 + (h)) * HTB)
#define PG8_SB(b, h) ((4 + (b) * 2 + (h)) * HTB)
#define PG8_STAGE(bufoff, gbase, voff) do { _Pragma("unroll") for (int _i = 0; _i < 2; ++_i) \
        __builtin_amdgcn_global_load_lds((const unsigned*)((const char*)(gbase) + (voff)[_i]), (LAS unsigned*)(lds + (bufoff) + ldsw + _i * 8192), 16, 0, 0); } while (0)
#define PG8_LDA(dst, b, h) do { _Pragma("unroll") for (int m = 0; m < 4; ++m) _Pragma("unroll") for (int k = 0; k < 2; ++k) dst[m][k] = *(const LAS bf16x8*)(lds + PG8_SA(b, h) + aoff + m * 2048 + k * 1024); } while (0)
#define PG8_LDB(dst, b, h) do { _Pragma("unroll") for (int n = 0; n < 2; ++n) _Pragma("unroll") for (int k = 0; k < 2; ++k) dst[n][k] = *(const LAS bf16x8*)(lds + PG8_SB(b, h) + boff + n * 2048 + k * 1024); } while (0)
#define PG8_MMA(ai, bj, At, Bt) do { __builtin_amdgcn_s_setprio(1); _Pragma("unroll") for (int m = 0; m < 4; ++m) _Pragma("unroll") for (int n = 0; n < 2; ++n) _Pragma("unroll") for (int k = 0; k < 2; ++k) \
        acc[ai][bj][m][n] = __builtin_amdgcn_mfma_f32_16x16x32_bf16(Bt[n][k], At[m][k], acc[ai][bj][m][n], 0, 0, 0); __builtin_amdgcn_s_setprio(0); } while (0)
#define PG8_WAIT_V(n) asm volatile("s_waitcnt vmcnt(" #n ")" ::: "memory")
#define PG8_WAIT_L(n) asm volatile("s_waitcnt lgkmcnt(" #n ")" ::: "memory")
#define PG8_BAR __builtin_amdgcn_s_barrier()
#define PG8_SCHED __builtin_amdgcn_sched_barrier(0)
    Unit cur, nxt; int ui = 0;
    if (!S.next(0, cur)) return;
    f32x4 acc[2][2][4][2];
#pragma unroll
    for (int a = 0; a < 2; ++a)
#pragma unroll
        for (int b = 0; b < 2; ++b)
#pragma unroll
            for (int m = 0; m < 4; ++m)
#pragma unroll
                for (int n = 0; n < 2; ++n) acc[a][b][m][n] = (f32x4){0.f, 0.f, 0.f, 0.f};
    bf16x8 At[4][2], B0[2][2], B1[2][2];
    const char* cA = (const char*)g.A + (size_t)cur.pm * tstep; const char* cB = (const char*)g.Bt + (size_t)cur.pn * tstep;
    PG8_STAGE(PG8_SB(0, 0), cB, voffB); PG8_STAGE(PG8_SA(0, 0), cA, voffA); PG8_STAGE(PG8_SB(0, 1), cB + hstep, voffB); PG8_STAGE(PG8_SA(0, 1), cA + hstepA, voffA);
    if (wr == 1) PG8_BAR;
    PG8_WAIT_V(4); PG8_BAR;
    PG8_STAGE(PG8_SB(1, 0), cB + kstep, voffB); PG8_STAGE(PG8_SA(1, 0), cA + kstep, voffA); PG8_STAGE(PG8_SB(1, 1), cB + hstep + kstep, voffB);
    PG8_WAIT_V(6); PG8_BAR;
    for (;;) {
        const bool has_next = S.next(ui + 1, nxt);
        const char* nA = has_next ? (const char*)g.A + (size_t)nxt.pm * tstep : cA; const char* nB = has_next ? (const char*)g.Bt + (size_t)nxt.pn * tstep : cB;
        for (int t = 0; t < nt; t += 2) {
            const bool last = (t == nt - 2);
            const char* a1 = cA + (size_t)(t + 1) * kstep;
            const char* a2 = last ? nA : cA + (size_t)(t + 2) * kstep; const char* b2 = last ? nB : cB + (size_t)(t + 2) * kstep;
            const char* a3 = a2 + kstep; const char* b3 = b2 + kstep;
            PG8_LDB(B0, 0, 0); PG8_SCHED; PG8_LDA(At, 0, 0); PG8_STAGE(PG8_SA(1, 1), a1 + hstepA, voffA);
            PG8_WAIT_L(8); PG8_BAR; PG8_WAIT_L(0); PG8_MMA(0, 0, At, B0); PG8_BAR; PG8_SCHED;
            PG8_LDB(B1, 0, 1); PG8_STAGE(PG8_SB(0, 0), b2, voffB);
            PG8_BAR; PG8_WAIT_L(0); PG8_MMA(0, 1, At, B1); PG8_BAR;
            PG8_LDA(At, 0, 1); PG8_STAGE(PG8_SA(0, 0), a2, voffA);
            PG8_BAR; PG8_WAIT_L(0); PG8_MMA(1, 0, At, B0); PG8_BAR; PG8_SCHED;
            PG8_STAGE(PG8_SB(0, 1), b2 + hstep, voffB);
            PG8_WAIT_V(6); PG8_BAR; PG8_MMA(1, 1, At, B1); PG8_BAR;
            PG8_LDB(B0, 1, 0); PG8_SCHED; PG8_LDA(At, 1, 0); PG8_STAGE(PG8_SA(0, 1), a2 + hstepA, voffA);
            PG8_WAIT_L(8); PG8_BAR; PG8_WAIT_L(0); PG8_MMA(0, 0, At, B0); PG8_BAR; PG8_SCHED;
            PG8_LDB(B1, 1, 1); PG8_STAGE(PG8_SB(1, 0), b3, voffB);
            PG8_BAR; PG8_WAIT_L(0); PG8_MMA(0, 1, At, B1); PG8_BAR;
            PG8_LDA(At, 1, 1); PG8_STAGE(PG8_SA(1, 0), a3, voffA);
            PG8_BAR; PG8_WAIT_L(0); PG8_MMA(1, 0, At, B0); PG8_BAR; PG8_SCHED;
            PG8_STAGE(PG8_SB(1, 1), b3 + hstep, voffB);
            PG8_WAIT_V(6); PG8_BAR; PG8_MMA(1, 1, At, B1); PG8_BAR;
        }
        const bool rst = E(acc, cur, wr, wc, fr, fq);
        if (!has_next) break;
        if (rst) {
#pragma unroll
        for (int a = 0; a < 2; ++a)
#pragma unroll
            for (int b = 0; b < 2; ++b)
#pragma unroll
                for (int m = 0; m < 4; ++m)
#pragma unroll
                    for (int n = 0; n < 2; ++n) acc[a][b][m][n] = (f32x4){0.f, 0.f, 0.f, 0.f}; }
        cur = nxt; cA = nA; cB = nB; ++ui;
    }
    PG8_WAIT_V(0);
    if (wr == 0) PG8_BAR;
    PG8_BAR;
#undef PG8_SA
#undef PG8_SB
#undef PG8_STAGE
#undef PG8_LDA
#undef PG8_LDB
#undef PG8_MMA
#undef PG8_WAIT_V
#undef PG8_WAIT_L
#undef PG8_BAR
#undef PG8_SCHED
}
}

DEV int map_col(int n, int Nsrc, int mode) {
    if (mode == 1) { if (n < 4096) { const int U = n >> 8, c = n & 255; const int fq = (c >> 3) & 3; const int t = (c >> 7) * 2 + ((c >> 2) & 1), ch = 64 * U + ((c >> 5) & 3) * 16 + (fq & 1) * 8 + (fq >> 1) * 4 + (c & 3); return t * 1024 + ch; }
        if (n < 5632) return n;
        if (n < 6656) return 6704 + (n - 5632);
        if (n < 10752) { const int m = n - 6656, U = m >> 8, c = m & 255;
            const int fq = (c >> 3) & 3; const int t = (c >> 7) * 2 + ((c >> 2) & 1), ch = 64 * U + ((c >> 5) & 3) * 16 + (fq & 1) * 8 + (fq >> 1) * 4 + (c & 3);
            return (t == 0 ? 7728 : t == 1 ? 8752 : t == 2 ? 9776 : 5680) + ch; }
        if (n < 10800) return n - 5120; return -1; }
    if (mode == 2) { const int pn = n >> 8, r = n & 255; return r < 128 ? 128 * pn + r : 3072 + 128 * pn + (r - 128); }
    return n < Nsrc ? n : -1;
}
DEV void lds_barrier() { asm volatile("s_waitcnt lgkmcnt(0)" ::: "memory"); __builtin_amdgcn_s_barrier(); asm volatile("" ::: "memory"); }
template <int NW>
DEV void convT(LAS unsigned char* lds, const float* src, int K, int Nsrc, bf16_t* dst, int Npad, int mode, int rot) {
    LAS float* tile = (LAS float*)lds;
    int tid = threadIdx.x; OPQV(tid); const int G = gridDim.x;
    constexpr int PW = NW + 1, NL = NW * 64 / 512, RPI = 512 / NW, TPN = 512 / NW, KS = 64 / TPN;
    const int ntk = K / 64, ntn = Npad / NW, ntiles = ntk * ntn;
    const int n = tid % NW, kr = tid / NW;
    int tix = (blockIdx.x + G - (rot % G)) % G;
    float ld[NL];
    if (tix < ntiles) { const int n0 = (tix / ntk) * NW, k0 = (tix % ntk) * 64; const int sc = map_col(n0 + n, Nsrc, mode);
#pragma unroll
        for (int i = 0; i < NL; ++i) ld[i] = sc >= 0 ? __builtin_nontemporal_load(src + (size_t)(k0 + i * RPI + kr) * Nsrc + sc) : 0.f; }
    for (; tix < ntiles; tix += G) {
        const int n0 = (tix / ntk) * NW, k0 = (tix % ntk) * 64;
#pragma unroll
        for (int i = 0; i < NL; ++i) tile[(i * RPI + kr) * PW + n] = ld[i];
        lds_barrier();
        const int tnx = tix + G;
        if (tnx < ntiles) { const int n1 = (tnx / ntk) * NW, k1 = (tnx % ntk) * 64; const int sc = map_col(n1 + n, Nsrc, mode);
#pragma unroll
            for (int i = 0; i < NL; ++i) ld[i] = sc >= 0 ? __builtin_nontemporal_load(src + (size_t)(k1 + i * RPI + kr) * Nsrc + sc) : 0.f; }
        { const int nn = tid / TPN, ks = (tid % TPN) * KS;
#pragma unroll
            for (int h = 0; h < KS / 8; ++h) { float v[8];
#pragma unroll
                for (int j = 0; j < 8; ++j) v[j] = tile[(ks + h * 8 + j) * PW + nn];
                *(u32x4*)(dst + (size_t)(n0 + nn) * K + k0 + ks + h * 8) = pack8(v); } }
        lds_barrier();
    }
}
DEV float wave_sum(float v) {
#pragma unroll
    for (int o = 32; o >= 1; o >>= 1) v += __shfl_xor(v, o);
    return v;
}
template <int RB>
DEV void rmsnorm_rows(const float* srcf, const bf16_t* srcb, const float* gamma, bf16_t* H, bf16_t* cpy, float* outn, int row0, int lane) {
    float v[RB][16];
    if (srcf) {
#pragma unroll
        for (int r = 0; r < RB; ++r)
#pragma unroll
            for (int hf = 0; hf < 2; ++hf) { const f32x4 a = *(const f32x4*)(srcf + (size_t)(row0 + r) * 1024 + hf * 512 + lane * 8), b2 = *(const f32x4*)(srcf + (size_t)(row0 + r) * 1024 + hf * 512 + lane * 8 + 4);
#pragma unroll
                for (int j = 0; j < 4; ++j) { v[r][hf * 8 + j] = a[j]; v[r][hf * 8 + 4 + j] = b2[j]; } }
    } else {
        u32x4 raw[RB][2];
#pragma unroll
        for (int r = 0; r < RB; ++r)
#pragma unroll
            for (int hf = 0; hf < 2; ++hf) raw[r][hf] = *(const u32x4*)(srcb + (size_t)(row0 + r) * 1024 + hf * 512 + lane * 8);
#pragma unroll
        for (int r = 0; r < RB; ++r)
#pragma unroll
            for (int hf = 0; hf < 2; ++hf) { float t8[8]; unpack8(raw[r][hf], t8);
#pragma unroll
                for (int j = 0; j < 8; ++j) v[r][hf * 8 + j] = t8[j]; }
    }
    f32x4 g0[2], g1[2];
#pragma unroll
    for (int hf = 0; hf < 2; ++hf) { g0[hf] = *(const f32x4*)(gamma + hf * 512 + lane * 8); g1[hf] = *(const f32x4*)(gamma + hf * 512 + lane * 8 + 4); }
#pragma unroll
    for (int r = 0; r < RB; ++r) {
        float ss = 0.f;
#pragma unroll
        for (int j = 0; j < 16; ++j) ss += v[r][j] * v[r][j];
        ss = wave_sum(ss);
        const float rs = rsqrtf(ss * (1.f / 1024.f) + EPS_);
        const int row = row0 + r;
#pragma unroll
        for (int hf = 0; hf < 2; ++hf) { const int c = hf * 512 + lane * 8;
            float y[8], x8[8];
#pragma unroll
            for (int j = 0; j < 4; ++j) { y[j] = v[r][hf * 8 + j] * rs * g0[hf][j]; y[4 + j] = v[r][hf * 8 + 4 + j] * rs * g1[hf][j]; }
#pragma unroll
            for (int j = 0; j < 8; ++j) x8[j] = v[r][hf * 8 + j];
            if (cpy) *(u32x4*)(cpy + (size_t)row * 1024 + c) = pack8(x8);
            if (outn) { *(f32x4*)(outn + (size_t)row * 1024 + c) = (f32x4){y[0], y[1], y[2], y[3]}; *(f32x4*)(outn + (size_t)row * 1024 + c + 4) = (f32x4){y[4], y[5], y[6], y[7]}; }
            if (H) *(u32x4*)(H + (size_t)row * 1024 + c) = pack8(y); }
    }
}
DEV void phase_rmsnorm(const float* srcf, const bf16_t* srcb, const float* gamma, bf16_t* H, bf16_t* cpy, float* outn) {
    int tid = threadIdx.x; OPQV(tid); const int lane = tid & 63, wave = tid >> 6;
    for (int rq = blockIdx.x * 8 + wave; rq < T_ / 4; rq += gridDim.x * 8) rmsnorm_rows<4>(srcf, srcb, gamma, H, cpy, outn, rq * 4, lane);
}
DEV void phase_rowpass(const bf16_t* P, const float* conv_a, const float* lng, const float* lnb, bf16_t* OA, bf16_t* VN, const float* GLA, const float* GFA) {
    int tid = threadIdx.x; OPQV(tid); const int lane = tid & 63, wave = tid >> 6;
    for (int idx = blockIdx.x * 512 + tid; idx < 64 * 2 * 256; idx += gridDim.x * 512) {
        const int pm = idx >> 9, r = idx & 511, t = r >> 8, c = (r & 255) * 4;
        const bool first = (pm & 7) == 0;
        const float* gf = GFA + ((size_t)(pm * 2 + t) * 2) * 1024 + c;
        const float* gl = GLA + (size_t)(first ? 0 : pm - 1) * 2 * 1024 + c;
        const f32x4 gb = *(const f32x4*)gf, x0 = *(const f32x4*)(gf + 1024);
        f32x4 xm1 = t == 0 ? *(const f32x4*)(gl + 1024) : *(const f32x4*)(GFA + ((size_t)(pm * 2) * 2) * 1024 + 1024 + c);
        f32x4 xm2 = t == 0 ? *(const f32x4*)gl : *(const f32x4*)(gl + 1024);
        if (first) { xm2 = (f32x4){0.f, 0.f, 0.f, 0.f}; if (t == 0) xm1 = xm2; }
        const f32x4 w0 = *(const f32x4*)(conv_a + c), w1 = *(const f32x4*)(conv_a + 1024 + c), w2 = *(const f32x4*)(conv_a + 2048 + c);
        const f32x4 y = gb * (w0 * xm2 + w1 * xm1 + w2 * x0);
        u32x2 o; o.x = cvt_pk_bf16(y[0], y[1]); o.y = cvt_pk_bf16(y[2], y[3]);
        *(u32x2*)(OA + ((size_t)pm * 256 + t) * 1024 + c) = o;
    }
    f32x4 g0[2], g1[2], b0[2], b1[2];
#pragma unroll
    for (int hlf = 0; hlf < 2; ++hlf) { const int c = hlf * 512 + lane * 8; g0[hlf] = *(const f32x4*)(lng + c); g1[hlf] = *(const f32x4*)(lng + c + 4); b0[hlf] = *(const f32x4*)(lnb + c); b1[hlf] = *(const f32x4*)(lnb + c + 4); }
    for (int rp = blockIdx.x * 8 + wave; rp < T_ / 2; rp += gridDim.x * 8) {
        const int row = rp * 2;
        const bf16_t* pr = P + (size_t)row * NP;
        u32x4 vr[2][2];
#pragma unroll
        for (int r = 0; r < 2; ++r)
#pragma unroll
            for (int hlf = 0; hlf < 2; ++hlf) vr[r][hlf] = *(const u32x4*)(pr + (size_t)r * NP + COL_V + hlf * 512 + lane * 8);
#pragma unroll
        for (int r = 0; r < 2; ++r) {
            float v[2][8]; float sm = 0.f;
#pragma unroll
            for (int hlf = 0; hlf < 2; ++hlf) { unpack8(vr[r][hlf], v[hlf]);
#pragma unroll
                for (int j = 0; j < 8; ++j) sm += v[hlf][j]; }
            const float mu = wave_sum(sm) * (1.f / 1024.f);
            float q = 0.f;
#pragma unroll
            for (int hlf = 0; hlf < 2; ++hlf)
#pragma unroll
                for (int j = 0; j < 8; ++j) { const float d = v[hlf][j] - mu; q += d * d; }
            const float rstd = rsqrtf(wave_sum(q) * (1.f / 1024.f) + EPS_);
#pragma unroll
            for (int hlf = 0; hlf < 2; ++hlf) { const int c = hlf * 512 + lane * 8; float o[8];
#pragma unroll
                for (int j = 0; j < 4; ++j) { o[j] = (v[hlf][j] - mu) * rstd * g0[hlf][j] + b0[hlf][j]; o[4 + j] = (v[hlf][4 + j] - mu) * rstd * g1[hlf][j] + b1[hlf][j]; }
                *(u32x4*)(VN + (size_t)(row + r) * 1024 + c) = pack8(o); }
        }
    }
}
DEV void phase_compress(LAS unsigned char* lds, const bf16_t* KV, const float* pos  , const bf16_t* W1T, const bf16_t* W2T, bf16_t* KC, bf16_t* VC) {
    int tid = threadIdx.x; OPQV(tid); const int lane = tid & 63, wv = tid >> 6, fr = lane & 15, g4 = lane >> 4;
    constexpr int PP = 132, HIDO = 4 * 32 * PP * 4;
    LAS float* PART = (LAS float*)lds;
    LAS bf16_t* HID = (LAS bf16_t*)(lds + HIDO);
    for (int item = blockIdx.x; item < 256; item += gridDim.x) {
        const int w = item >> 7, b = (item >> 4) & 7, g = (item >> 2) & 3, qr = item & 3;
        const int kq = wv >> 1, nh = wv & 1;
        const float* posw = pos + w * 2048;
        const bf16_t* w1 = W1T + (size_t)w * 128 * 2048 + (size_t)(nh * 64 + fr) * 2048 + g4 * 8;
        f32x4 acc[2][4];
#pragma unroll
        for (int mt = 0; mt < 2; ++mt)
#pragma unroll
            for (int nt = 0; nt < 4; ++nt) acc[mt][nt] = (f32x4){0.f, 0.f, 0.f, 0.f};
        const int n0 = qr * 32 + fr, n1 = n0 + 16;
        const bool ok0 = n0 < 127, ok1 = n1 < 127;
        const bf16_t* x0 = KV + (size_t)w * KV_TENSOR + ((size_t)(b * 4 + g) * S_ + 16 * min(n0, 126)) * 64 + g4 * 8;
        const bf16_t* x1 = KV + (size_t)w * KV_TENSOR + ((size_t)(b * 4 + g) * S_ + 16 * min(n1, 126)) * 64 + g4 * 8;
#pragma unroll 4
        for (int ks = 0; ks < 16; ++ks) { const int kk = kq * 16 + ks, i = kk >> 1, db = (kk & 1) * 32;
            const f32x4 p0 = *(const f32x4*)(posw + i * 64 + db + g4 * 8), p1 = *(const f32x4*)(posw + i * 64 + db + g4 * 8 + 4);
            const u32x4 xa = *(const u32x4*)(x0 + i * 64 + db);
            const u32x4 xb = *(const u32x4*)(x1 + i * 64 + db);
            bf16x8 bfr[4];
#pragma unroll
            for (int nt = 0; nt < 4; ++nt) bfr[nt] = *(const bf16x8*)(w1 + (size_t)nt * 16 * 2048 + kk * 32);
            float a[8];
            unpack8(xa, a);
#pragma unroll
            for (int j = 0; j < 4; ++j) { a[j] += p0[j]; a[4 + j] += p1[j]; }
#pragma unroll
            for (int j = 0; j < 8; ++j) a[j] = ok0 ? a[j] : 0.f;
            const bf16x8 af0 = as_bf16x8(pack8(a));
            unpack8(xb, a);
#pragma unroll
            for (int j = 0; j < 4; ++j) { a[j] += p0[j]; a[4 + j] += p1[j]; }
#pragma unroll
            for (int j = 0; j < 8; ++j) a[j] = ok1 ? a[j] : 0.f;
            const bf16x8 af1 = as_bf16x8(pack8(a));
#pragma unroll
            for (int nt = 0; nt < 4; ++nt) { acc[0][nt] = __builtin_amdgcn_mfma_f32_16x16x32_bf16(af0, bfr[nt], acc[0][nt], 0, 0, 0);
                acc[1][nt] = __builtin_amdgcn_mfma_f32_16x16x32_bf16(af1, bfr[nt], acc[1][nt], 0, 0, 0); }
        }
#pragma unroll
        for (int mt = 0; mt < 2; ++mt)
#pragma unroll
            for (int nt = 0; nt < 4; ++nt)
#pragma unroll
                for (int r = 0; r < 4; ++r) PART[(kq * 32 + mt * 16 + g4 * 4 + r) * PP + nh * 64 + nt * 16 + fr] = acc[mt][nt][r];
        __syncthreads();
        { const int row = tid >> 4, c8 = (tid & 15) * 8; float hv[8];
#pragma unroll
            for (int j = 0; j < 8; ++j) hv[j] = 0.f;
#pragma unroll
            for (int q = 0; q < 4; ++q) { const f32x4 u0 = *(const LAS f32x4*)(lds + ((q * 32 + row) * PP + c8) * 4), u1 = *(const LAS f32x4*)(lds + ((q * 32 + row) * PP + c8 + 4) * 4);
#pragma unroll
                for (int j = 0; j < 4; ++j) { hv[j] += u0[j]; hv[4 + j] += u1[j]; } }
#pragma unroll
            for (int j = 0; j < 8; ++j) hv[j] = gelu_t(hv[j]);
            *(LAS u32x4*)(lds + HIDO + (row * 136 + c8) * 2) = pack8(hv); }
        __syncthreads();
        { const int mt = wv >> 2, dt = wv & 3;
            const bf16_t* w2 = W2T + (size_t)w * 64 * 128 + (size_t)(dt * 16 + fr) * 128;
            f32x4 o = (f32x4){0.f, 0.f, 0.f, 0.f};
#pragma unroll
            for (int ks = 0; ks < 4; ++ks) { const bf16x8 af = *(const LAS bf16x8*)(lds + HIDO + ((mt * 16 + fr) * 136 + ks * 32 + g4 * 8) * 2);
                const bf16x8 bfr = *(const bf16x8*)(w2 + ks * 32 + g4 * 8);
                o = __builtin_amdgcn_mfma_f32_16x16x32_bf16(af, bfr, o, 0, 0, 0); }
            bf16_t* dst = (w ? VC : KC) + (size_t)(b * 4 + g) * 128 * 64;
#pragma unroll
            for (int r = 0; r < 4; ++r) { const int n = qr * 32 + mt * 16 + g4 * 4 + r; const float ov = n < 127 ? o[r] : 0.f;
                dst[n * 64 + dt * 16 + fr] = (bf16_t)(cvt_pk_bf16(ov, 0.f) & 0xffffu); } }
        __syncthreads();
    }
}
DEV void sgu_item(LAS unsigned char* lds, const bf16_t* P, const bf16_t* VN, const float* sgu_w, const float* sgu_b, bf16_t* OC, int item) {
    int tid = threadIdx.x; OPQV(tid); const int lane = tid & 63, wv = tid >> 6, fr = lane & 15, g4 = lane >> 4;
    LAS bf16_t* VT = (LAS bf16_t*)lds;
    const int g = item & 7, ch = (item >> 3) & 15, b = item >> 7;
    const size_t tok0 = (size_t)b * S_ + ch * 128;
    const int t = wv * 16 + fr;
    const size_t tok = tok0 + t;
    u32x4 vin[4];
#pragma unroll
    for (int it = 0; it < 4; ++it) { const int idx = it * 512 + tid, s = idx >> 4, c8 = (idx & 15) * 8; vin[it] = *(const u32x4*)(VN + (tok0 + s) * 1024 + g * 128 + c8); }
    const float* wrow = sgu_w + ((size_t)g * 128 + t) * 128;
    f32x4 wa[4], wb[4];
#pragma unroll
    for (int ks = 0; ks < 4; ++ks) { wa[ks] = *(const f32x4*)(wrow + ks * 32 + g4 * 8); wb[ks] = *(const f32x4*)(wrow + ks * 32 + g4 * 8 + 4); }
    u32x2 uu[8];
#pragma unroll
    for (int n = 0; n < 8; ++n) uu[n] = *(const u32x2*)(P + tok * NP + COL_U + g * 128 + n * 16 + g4 * 4);
    const float bias = sgu_b[g * 128 + t];
#pragma unroll
    for (int it = 0; it < 4; ++it) { const int idx = it * 512 + tid, s = idx >> 4, c8 = (idx & 15) * 8;
#pragma unroll
        for (int j = 0; j < 4; ++j) { VT[(c8 + 2 * j) * 136 + s] = (bf16_t)(vin[it][j] & 0xffffu); VT[(c8 + 2 * j + 1) * 136 + s] = (bf16_t)(vin[it][j] >> 16); } }
    __syncthreads();
    f32x4 acc[8];
#pragma unroll
    for (int n = 0; n < 8; ++n) acc[n] = (f32x4){0.f, 0.f, 0.f, 0.f};
#pragma unroll
    for (int ks = 0; ks < 4; ++ks) { const int s0 = ks * 32 + g4 * 8;
        float wf[8] = {wa[ks][0], wa[ks][1], wa[ks][2], wa[ks][3], wb[ks][0], wb[ks][1], wb[ks][2], wb[ks][3]};
#pragma unroll
        for (int j = 0; j < 8; ++j) if (s0 + j > t) wf[j] = 0.f;
        const bf16x8 wfr = as_bf16x8(pack8(wf));
#pragma unroll
        for (int n = 0; n < 8; ++n) { const bf16x8 vf = *(const LAS bf16x8*)(lds + ((n * 16 + fr) * 136 + s0) * 2);
            acc[n] = __builtin_amdgcn_mfma_f32_16x16x32_bf16(vf, wfr, acc[n], 0, 0, 0); } }
#pragma unroll
    for (int n = 0; n < 8; ++n) { const int c = g * 128 + n * 16 + g4 * 4;
        u32x2 w; w.x = cvt_pk_bf16(bflo(uu[n].x) * (acc[n][0] + bias), bfhi(uu[n].x) * (acc[n][1] + bias)); w.y = cvt_pk_bf16(bflo(uu[n].y) * (acc[n][2] + bias), bfhi(uu[n].y) * (acc[n][3] + bias));
        *(u32x2*)(OC + tok * 1024 + c) = w; }
    __syncthreads();
}
DEV void phase_actfix(const float* GL, const float* GF, const float* cw, bf16_t* ACT, int pm0, int npm) {
    int tid = threadIdx.x; OPQV(tid);
    for (int idx = tid; idx < npm * 768; idx += 512) {
        const int pm = pm0 + idx / 768, r = idx % 768, t = r / 384, c = (r - t * 384) * 8;
        const bool first = (pm & 7) == 0;
        const float* gf = GF + ((size_t)(pm * 2 + t) * 2) * DFF + c;
        const float* gl = GL + (size_t)(first ? 0 : pm - 1) * 2 * DFF + c;
        const float* gm1p = t == 0 ? gl + DFF : GF + ((size_t)(pm * 2) * 2) * DFF + c;
        const float* gm2p = t == 0 ? gl : gl + DFF;
        float y[8];
#pragma unroll
        for (int hf = 0; hf < 2; ++hf) { const f32x4 g0 = *(const f32x4*)(gf + hf * 4), vv = *(const f32x4*)(gf + DFF + hf * 4);
            f32x4 gm1 = *(const f32x4*)(gm1p + hf * 4), gm2 = *(const f32x4*)(gm2p + hf * 4);
            if (first) { gm2 = (f32x4){0.f, 0.f, 0.f, 0.f}; if (t == 0) gm1 = gm2; }
            const f32x4 w0 = *(const f32x4*)(cw + c + hf * 4), w1 = *(const f32x4*)(cw + DFF + c + hf * 4), w2 = *(const f32x4*)(cw + 2 * DFF + c + hf * 4);
#pragma unroll
            for (int j = 0; j < 4; ++j) y[hf * 4 + j] = gelu_t(w0[j] * gm2[j] + w1[j] * gm1[j] + w2[j] * g0[j]) * vv[j]; }
        *(u32x4*)(ACT + ((size_t)pm * 256 + t) * DFF + c) = pack8(y);
    }
}

constexpr int AT_KS = 0, AT_VT = 18432, AT_BT = 36864, AT_BK = 38944, AT_IMP = 39936, AT_MASK = 72704, AT_IMPF = 72960, AT_RB = 81152, AT_NEXT = 83200;

struct KVRegs { u32x4 k, v; };
DEV KVRegs kv_fetch(const bf16_t* kbase, const bf16_t* vbase, int tid) {
    KVRegs r;
    r.k = *(const u32x4*)(kbase + tid * 8); r.v = *(const u32x4*)(vbase + (tid & 63) * 64 + (tid >> 6) * 8); return r;
}
DEV void kv_store(LAS unsigned char* lds, const KVRegs& r, int buf, int tid) {
    const int key = tid >> 3, c8 = (tid & 7) * 8;
    unsigned kw = AT_KS + buf * 9216 + (key * 72 + c8) * 2, vw = AT_VT + buf * 9216 + ((tid >> 6) * 8 * 72 + (tid & 63)) * 2; OPQV(kw); OPQV(vw);
    *(LAS u32x4*)(lds + kw) = r.k;
#pragma unroll
    for (int j = 0; j < 4; ++j) { *(LAS bf16_t*)(lds + vw + j * 288) = (bf16_t)(r.v[j] & 0xffffu); *(LAS bf16_t*)(lds + vw + j * 288 + 144) = (bf16_t)(r.v[j] >> 16); }
}

DEV void attn_tile(LAS unsigned char* lds, const bf16x8 (&qf)[2][2], int tl, int kpos0, int mode, bool near, bool wedge, bool rowsel, const float (&cbias)[2],
                   unsigned kb, unsigned vb_, unsigned btb, int g4, float (&mrun)[2], float (&lrun)[2], f32x4 (&O)[2][4]) {
    f32x4 sc[2][4];
    float ci[2];
#pragma unroll
    for (int hh = 0; hh < 2; ++hh) { const float mne = mrun[hh] < -1e29f ? 0.f : mrun[hh];
        ci[hh] = (mode == 1 && !rowsel) ? NEG_ : ((near && !wedge) ? -mne : cbias[hh] - mne); }
    {
        bf16x8 kf[4][2];
#pragma unroll
        for (int kt = 0; kt < 4; ++kt) { kf[kt][0] = *(const LAS bf16x8*)(lds + kb + kt * 2304); kf[kt][1] = *(const LAS bf16x8*)(lds + kb + kt * 2304 + 64); }
        __builtin_amdgcn_sched_barrier(0);
#pragma unroll
        for (int kt = 0; kt < 4; ++kt)
#pragma unroll
            for (int hh = 0; hh < 2; ++hh) sc[hh][kt] = __builtin_amdgcn_mfma_f32_16x16x32_bf16(kf[kt][0], qf[hh][0], (f32x4){ci[hh], ci[hh], ci[hh], ci[hh]}, 0, 0, 0);
#pragma unroll
        for (int kt = 0; kt < 4; ++kt)
#pragma unroll
            for (int hh = 0; hh < 2; ++hh) sc[hh][kt] = __builtin_amdgcn_mfma_f32_16x16x32_bf16(kf[kt][1], qf[hh][1], sc[hh][kt], 0, 0, 0);
    }
    if (wedge) {
#pragma unroll
        for (int kt = 0; kt < 4; ++kt)
#pragma unroll
            for (int r = 0; r < 4; ++r) { const bool valid = tl - (kpos0 + kt * 16 + g4 * 4 + r) < 512;
#pragma unroll
                for (int hh = 0; hh < 2; ++hh) sc[hh][kt][r] = valid ? sc[hh][kt][r] : NEG_; }
    } else if (near) {
#pragma unroll
        for (int kt = 0; kt < 4; ++kt)
#pragma unroll
            for (int r = 0; r < 4; ++r) { const int dist = tl - (kpos0 + kt * 16 + g4 * 4 + r);
                const int idx = (dist < -1 ? -1 : (dist > 128 ? 128 : dist)) + 1;
#pragma unroll
                for (int hh = 0; hh < 2; ++hh) sc[hh][kt][r] = sc[hh][kt][r] + *(const LAS float*)(lds + btb + idx * 4 + hh * 520); }
    }
    bf16x8 pf[2][2];
#pragma unroll
    for (int hh = 0; hh < 2; ++hh) {
        float lm = fmaxf(fmaxf(sc[hh][0][0], sc[hh][0][1]), fmaxf(sc[hh][0][2], sc[hh][0][3]));
#pragma unroll
        for (int kt = 1; kt < 4; ++kt) lm = fmaxf(lm, fmaxf(fmaxf(sc[hh][kt][0], sc[hh][kt][1]), fmaxf(sc[hh][kt][2], sc[hh][kt][3])));
        const bool inval = mrun[hh] < -1e29f;
        if (__any(lm > (inval ? -1e29f : 20.f))) {
            float mx = fmaxf(lm, __shfl_xor(lm, 16)); mx = fmaxf(mx, __shfl_xor(mx, 32));
            float d = 0.f, alpha = 1.f;
            if (mx > -1e29f) { d = inval ? mx : fmaxf(mx, 0.f); alpha = inval ? 1.f : __builtin_amdgcn_exp2f(-d); mrun[hh] = inval ? mx : mrun[hh] + d; }
#pragma unroll
            for (int kt = 0; kt < 4; ++kt) sc[hh][kt] = sc[hh][kt] - d;
            lrun[hh] *= alpha;
#pragma unroll
            for (int dt = 0; dt < 4; ++dt) O[hh][dt] = O[hh][dt] * alpha;
        }
        float rs = 0.f;
#pragma unroll
        for (int kt = 0; kt < 4; ++kt)
#pragma unroll
            for (int r = 0; r < 4; ++r) { const float p = __builtin_amdgcn_exp2f(sc[hh][kt][r]); sc[hh][kt][r] = p; rs += p; }
        lrun[hh] += rs;
#pragma unroll
        for (int kc = 0; kc < 2; ++kc) { u32x4 w; w.x = cvt_pk_bf16(sc[hh][2 * kc][0], sc[hh][2 * kc][1]); w.y = cvt_pk_bf16(sc[hh][2 * kc][2], sc[hh][2 * kc][3]);
            w.z = cvt_pk_bf16(sc[hh][2 * kc + 1][0], sc[hh][2 * kc + 1][1]); w.w = cvt_pk_bf16(sc[hh][2 * kc + 1][2], sc[hh][2 * kc + 1][3]); pf[hh][kc] = as_bf16x8(w); }
    }
#pragma unroll
    for (int dt = 0; dt < 4; ++dt)
#pragma unroll
        for (int kc = 0; kc < 2; ++kc) {
            const u32x2 va = *(const LAS u32x2*)(lds + vb_ + dt * 2304 + kc * 64);
            const u32x2 vb = *(const LAS u32x2*)(lds + vb_ + dt * 2304 + kc * 64 + 32);
            const bf16x8 vf = as_bf16x8((u32x4){va.x, va.y, vb.x, vb.y});
#pragma unroll
            for (int hh = 0; hh < 2; ++hh) O[hh][dt] = __builtin_amdgcn_mfma_f32_16x16x32_bf16(vf, pf[hh][kc], O[hh][dt], 0, 0, 0);
        }
}

DEV void attn_item(LAS unsigned char* lds, const bf16_t* P, const bf16_t* QB, const bf16_t* KV, const bf16_t* KC, const bf16_t* VC, const float* rel_bias, bf16_t* OB, int b, int g, int qt) {
    int tid = threadIdx.x; OPQV(tid);
    const int lane = tid & 63, wave = tid >> 6, fr = lane & 15, g4 = lane >> 4;
    const int qs = wave >> 1, hp = wave & 1;
    const int tl = qt * 64 + qs * 16 + fr;
    const size_t tok = (size_t)b * S_ + tl;
    unsigned kb = AT_KS + (fr * 72 + g4 * 8) * 2, vb1 = AT_VT + (fr * 72 + g4 * 4) * 2, vb2 = AT_VT + (fr * 136 + g4 * 4) * 2, btb = AT_BT + hp * 1040;
    OPQV(kb); OPQV(vb1); OPQV(vb2); OPQV(btb);
    LAS float* BT = (LAS float*)(lds + AT_BT);
    const LAS int* BK = (const LAS int*)(lds + AT_BK);
    LAS float* IA = (LAS float*)(lds + AT_IMP);
    LAS float* IB = (LAS float*)(lds + AT_IMP + 16384);
    LAS unsigned* MASK = (LAS unsigned*)(lds + AT_MASK);

    bf16x8 qf[2][2];
#pragma unroll
    for (int hh = 0; hh < 2; ++hh)
#pragma unroll
        for (int ks = 0; ks < 2; ++ks) { float qv[8]; unpack8(*(const u32x4*)(QB + tok * 1024 + (g * 4 + hp * 2 + hh) * 64 + ks * 32 + g4 * 8), qv);
#pragma unroll
            for (int e = 0; e < 8; ++e) qv[e] *= QSC_;
            qf[hh][ks] = as_bf16x8(pack8(qv)); }
    float gate[3][2];
#pragma unroll
    for (int br = 0; br < 3; ++br)
#pragma unroll
        for (int hh = 0; hh < 2; ++hh) gate[br][hh] = bf2f(P[tok * NP + COL_GN + br * 16 + g * 4 + hp * 2 + hh]);
    f32x4 F[2][4];
#pragma unroll
    for (int hh = 0; hh < 2; ++hh)
#pragma unroll
        for (int dt = 0; dt < 4; ++dt) F[hh][dt] = (f32x4){0.f, 0.f, 0.f, 0.f};

    const bf16_t* pbg = KV + (size_t)(b * 4 + g) * S_ * 64;
    KVRegs pre = kv_fetch(pbg + 2 * KV_TENSOR, pbg + 3 * KV_TENSOR, tid);
    {
        const bf16_t* kc = KC + (size_t)(b * 4 + g) * 128 * 64; const bf16_t* vc = VC + (size_t)(b * 4 + g) * 128 * 64;
#pragma unroll
        for (int it = 0; it < 2; ++it) { const int idx = it * 512 + tid, key = idx >> 3, c8 = (idx & 7) * 8;
            const u32x4 kv = *(const u32x4*)(kc + key * 64 + c8); const u32x4 vv = *(const u32x4*)(vc + key * 64 + c8);
            unsigned kw = AT_KS + (key * 72 + c8) * 2, vw = AT_VT + (c8 * 136 + key) * 2; OPQV(kw); OPQV(vw);
            *(LAS u32x4*)(lds + kw) = kv;
#pragma unroll
            for (int j = 0; j < 4; ++j) { *(LAS bf16_t*)(lds + vw + j * 544) = (bf16_t)(vv[j] & 0xffffu); *(LAS bf16_t*)(lds + vw + j * 544 + 272) = (bf16_t)(vv[j] >> 16); } }
        for (int e = tid; e < 4 * 130; e += 512) { const int r = e / 130, k = e - r * 130; BT[e] = k == 0 ? NEG_ : LOG2E_ * *(const LAS float*)(lds + AT_RB + (BK[k - 1] * 16 + g * 4 + r) * 4); }
    }
    __syncthreads();
    {
        const int nkt = min(8, (4 * qt + 2) / 16 + 1);
        float ia[8], ib[8];
#pragma unroll
        for (int kt = 0; kt < 8; ++kt) { ia[kt] = 0.f; ib[kt] = 0.f; }
#pragma unroll
        for (int hh = 0; hh < 2; ++hh) {
            f32x4 sc[8];
#pragma unroll
            for (int kt = 0; kt < 8; ++kt) {
                if (kt < nkt) {
                    const bf16x8 k0 = *(const LAS bf16x8*)(lds + kb + kt * 2304);
                    const bf16x8 k1 = *(const LAS bf16x8*)(lds + kb + kt * 2304 + 64);
                    f32x4 a = (f32x4){0.f, 0.f, 0.f, 0.f};
                    a = __builtin_amdgcn_mfma_f32_16x16x32_bf16(k0, qf[hh][0], a, 0, 0, 0);
                    a = __builtin_amdgcn_mfma_f32_16x16x32_bf16(k1, qf[hh][1], a, 0, 0, 0);
#pragma unroll
                    for (int r = 0; r < 4; ++r) { const int n = kt * 16 + g4 * 4 + r; const int dist = tl - (16 * n + 31);
                        const int idx = (dist < -1 ? -1 : (dist > 128 ? 128 : dist)) + 1;
                        a[r] = a[r] + *(const LAS float*)(lds + btb + idx * 4 + hh * 520); }
                    sc[kt] = a;
                } else sc[kt] = (f32x4){NEG_, NEG_, NEG_, NEG_};
            }
            float mx = NEG_;
#pragma unroll
            for (int kt = 0; kt < 8; ++kt)
#pragma unroll
                for (int r = 0; r < 4; ++r) mx = fmaxf(mx, sc[kt][r]);
            mx = fmaxf(mx, __shfl_xor(mx, 16)); mx = fmaxf(mx, __shfl_xor(mx, 32));
            float rs = 0.f;
#pragma unroll
            for (int kt = 0; kt < 8; ++kt)
#pragma unroll
                for (int r = 0; r < 4; ++r) { const float s = sc[kt][r]; const float p = s > -1e29f ? __builtin_amdgcn_exp2f(s - mx) : 0.f; sc[kt][r] = p; rs += p; }
            rs += __shfl_xor(rs, 16); rs += __shfl_xor(rs, 32);
            const float inv = rs > 0.f ? 1.f / rs : 0.f;
#pragma unroll
            for (int kt = 0; kt < 8; ++kt) { sc[kt] = sc[kt] * inv; ia[kt] += (sc[kt][0] + sc[kt][1]) + (sc[kt][2] + sc[kt][3]); ib[kt] += sc[kt][3]; }
            f32x4 Oc[4];
#pragma unroll
            for (int dt = 0; dt < 4; ++dt) Oc[dt] = (f32x4){0.f, 0.f, 0.f, 0.f};
#pragma unroll
            for (int kc = 0; kc < 4; ++kc) {
                if (2 * kc < nkt) {
                    u32x4 w; w.x = cvt_pk_bf16(sc[2 * kc][0], sc[2 * kc][1]); w.y = cvt_pk_bf16(sc[2 * kc][2], sc[2 * kc][3]);
                    w.z = cvt_pk_bf16(sc[2 * kc + 1][0], sc[2 * kc + 1][1]); w.w = cvt_pk_bf16(sc[2 * kc + 1][2], sc[2 * kc + 1][3]);
                    const bf16x8 pf = as_bf16x8(w);
#pragma unroll
                    for (int dt = 0; dt < 4; ++dt) {
                        const u32x2 va = *(const LAS u32x2*)(lds + vb2 + dt * 4352 + kc * 64);
                        const u32x2 vb = *(const LAS u32x2*)(lds + vb2 + dt * 4352 + kc * 64 + 32);
                        const bf16x8 vf = as_bf16x8((u32x4){va.x, va.y, vb.x, vb.y});
                        Oc[dt] = __builtin_amdgcn_mfma_f32_16x16x32_bf16(vf, pf, Oc[dt], 0, 0, 0);
                    }
                }
            }
#pragma unroll
            for (int dt = 0; dt < 4; ++dt) F[hh][dt] = F[hh][dt] + Oc[dt] * gate[0][hh];
            __builtin_amdgcn_sched_barrier(0);
        }
        unsigned iw = AT_IMP + ((hp * 64 + qs * 16 + fr) * 32 + g4) * 4; OPQV(iw);
#pragma unroll
        for (int kt = 0; kt < 8; ++kt) { *(LAS float*)(lds + iw + kt * 16) = ia[kt]; *(LAS float*)(lds + iw + kt * 16 + 16384) = ib[kt]; }
    }
    __syncthreads();
    {
        LAS float* IMPF = (LAS float*)(lds + AT_IMPF);
#pragma unroll
        for (int it = 0; it < 4; ++it) { const int e = it * 512 + tid, q = e >> 5, j = e & 31;
            float v = IA[q * 32 + j] + IA[(64 + q) * 32 + j]; if (j > 0) v += IB[q * 32 + j - 1] + IB[(64 + q) * 32 + j - 1];
            IMPF[e] = v; }
        __syncthreads();
        const int cur = qt;
        const unsigned forced = 1u | (1u << cur) | (cur > 0 ? (1u << (cur - 1)) : 0u);
        const int need = 8 - __popc(forced);
        for (int it = 0; it < 4; ++it) { const int q = wave * 8 + it * 2 + (lane >> 5), j = lane & 31;
            const float v = IMPF[q * 32 + j]; int rank = 0;
            for (int jp = 1; jp <= cur - 2; ++jp) { const float vp = IMPF[q * 32 + jp]; rank += (vp > v || (vp == v && jp < j)) ? 1 : 0; }
            const bool sel = (j >= 1) && (j <= cur - 2) && (rank < need);
            const unsigned long long bal = __ballot(sel);
            const unsigned mq = forced | (unsigned)(lane < 32 ? bal : (bal >> 32));
            if (j == 0) MASK[q] = mq; }
    }
    __syncthreads();
    const unsigned mymask = MASK[qs * 16 + fr];
    unsigned anym = MASK[lane];
#pragma unroll
    for (int o = 32; o >= 1; o >>= 1) anym |= __shfl_xor(anym, o);
    anym = __builtin_amdgcn_readfirstlane(anym);
    {
        float cbias[2]; cbias[0] = *(const LAS float*)(lds + btb + 516); cbias[1] = *(const LAS float*)(lds + btb + 516 + 520);
        float mrun[2] = {NEG_, NEG_}, lrun[2] = {0.f, 0.f}; f32x4 O[2][4];
#pragma unroll
        for (int hh = 0; hh < 2; ++hh)
#pragma unroll
            for (int dt = 0; dt < 4; ++dt) O[hh][dt] = (f32x4){0.f, 0.f, 0.f, 0.f};
        unsigned rem = anym & (qt >= 31 ? 0xffffffffu : ((2u << qt) - 1u)); rem &= ~1u;
        int mode = 1, j = 0, buf = 0;
        for (;;) {
            kv_store(lds, pre, buf, tid);
            __syncthreads();
            int mode_n = mode, j_n = 0; bool more = true;
            if (mode == 1) { if (rem != 0u) { j_n = __builtin_ctz(rem); rem &= rem - 1u; } else { mode_n = 2; j_n = max(0, qt - 8); } }
            else { j_n = j + 1; more = j_n <= qt; }
            if (more) { const bf16_t* base = pbg + (size_t)j_n * 64 * 64 + (mode_n == 1 ? 2 : 4) * KV_TENSOR; pre = kv_fetch(base, base + KV_TENSOR, tid); }
            const bool near = (j >= qt - 2), wedge = (mode == 2 && j == qt - 8 && j < qt - 2);
            attn_tile(lds, qf, tl, j * 64, mode, near, wedge, ((mymask >> j) & 1u) != 0u, cbias, kb + buf * 9216, vb1 + buf * 9216, btb, g4, mrun, lrun, O);
            if (mode_n != mode || !more) {
#pragma unroll
                for (int hh = 0; hh < 2; ++hh) { float lt = lrun[hh]; lt += __shfl_xor(lt, 16); lt += __shfl_xor(lt, 32); const float sc = lt > 0.f ? gate[mode][hh] / lt : 0.f;
#pragma unroll
                    for (int dt = 0; dt < 4; ++dt) { F[hh][dt] = F[hh][dt] + O[hh][dt] * sc; O[hh][dt] = (f32x4){0.f, 0.f, 0.f, 0.f}; }
                    mrun[hh] = NEG_; lrun[hh] = 0.f; }
            }
            if (!more) break;
            mode = mode_n; j = j_n; buf ^= 1;
        }
    }
#pragma unroll
    for (int hh = 0; hh < 2; ++hh)
#pragma unroll
        for (int dt = 0; dt < 4; ++dt) { u32x2 w; w.x = cvt_pk_bf16(F[hh][dt][0], F[hh][dt][1]); w.y = cvt_pk_bf16(F[hh][dt][2], F[hh][dt][3]);
            *(u32x2*)(OB + tok * 1024 + (g * 4 + hp * 2 + hh) * 64 + dt * 16 + g4 * 4) = w; }
}

DEV void phase_mix(LAS unsigned char* lds, const bf16_t* P, const bf16_t* QB, const bf16_t* KV, const bf16_t* KC, const bf16_t* VC, const float* rel_bias, bf16_t* OB,
                   const bf16_t* VN, const float* sgu_w, const float* sgu_b, bf16_t* OC, int* ctr) {
    int tid = threadIdx.x; OPQV(tid);
    LAS int* BK = (LAS int*)(lds + AT_BK);
    if (tid < 129) { int bk; if (tid < 16) bk = tid; else { const float lr = log2f((float)tid * (1.f / 16.f)) * (1.f / 3.f); bk = 16 + (int)(lr * 16.f); if (bk > 31) bk = 31; } BK[tid] = bk; }
    *(LAS float*)(lds + AT_RB + tid * 4) = rel_bias[tid];
    __syncthreads();
    for (;;) {
        if (tid == 0) *(LAS int*)(lds + AT_NEXT) = atomicAdd(ctr, 1);
        __syncthreads();
        const int i = *(const LAS int*)(lds + AT_NEXT);
        __syncthreads();
        if (i >= 2048) break;
        if (i < 1024) attn_item(lds, P, QB, KV, KC, VC, rel_bias, OB, (i & 31) >> 2, i & 3, 31 - (i >> 5));
        else sgu_item(lds, P, VN, sgu_w, sgu_b, OC, i - 1024);
        __syncthreads();
    }
}


#define XB_TMO      128
#define XB_XCNT(j)  (256  + 64 * (j))
#define XB_XSUB(j)  (1280 + 64 * (j))
#define XB_XGEN(j)  (2304 + 64 * (j))
#define XB_TOP      3328
#define XB_TOPGEN   3392
#define XCD_BAR_WORDS 3456
#define XB_SPIN_CAP (1u << 20)
DEV unsigned xb_ld(unsigned* p)              { return __hip_atomic_load(p, __ATOMIC_RELAXED, __HIP_MEMORY_SCOPE_AGENT); }
DEV unsigned xb_add(unsigned* p, unsigned v) { return __hip_atomic_fetch_add(p, v, __ATOMIC_RELAXED, __HIP_MEMORY_SCOPE_AGENT); }
DEV unsigned xb_xcc_id() { return (unsigned)__builtin_amdgcn_s_getreg((3 << 11) | 20) & 0xFu; }
#define XB_SPIN(cond, bar) do { unsigned _sp = 0; while (cond) { __builtin_amdgcn_s_sleep(1); \
    if ((++_sp & 255u) == 0u) { if (xb_ld(&(bar)[XB_TMO])) break; if (_sp > XB_SPIN_CAP) { atomicAdd(&(bar)[XB_TMO], 1u); break; } } } } while (0)
struct XcdBarrier { unsigned* bar; unsigned x; volatile LAS unsigned* st; };
DEV XcdBarrier xcd_barrier_post(unsigned* bar, volatile LAS unsigned* st) {
    XcdBarrier b; b.bar = bar; b.x = xb_xcc_id(); b.st = st;
    if (threadIdx.x == 0) (void)xb_add(&bar[XB_XCNT(b.x)], 1u);
    return b;
}
DEV void xcd_barrier_complete(unsigned* bar, unsigned x, unsigned& nloc, unsigned& nx) {
    const unsigned G = gridDim.x * gridDim.y * gridDim.z;
    unsigned sum, cnt, mine, sp = 0u;
    for (;;) {
        sum = 0u; cnt = 0u; mine = 0u;
#pragma unroll
        for (unsigned j = 0; j < 16; ++j) { const unsigned c = xb_ld(&bar[XB_XCNT(j)]); sum += c; cnt += (c > 0u) ? 1u : 0u; mine = (j == x) ? c : mine; }
        if (sum == G) break;
        __builtin_amdgcn_s_sleep(1);
        if ((++sp & 255u) == 0u) { if (xb_ld(&bar[XB_TMO])) break; if (sp > XB_SPIN_CAP) { atomicAdd(&bar[XB_TMO], 1u); break; } }
    }
    nloc = mine > 0u ? mine : 1u; nx = cnt > 0u ? cnt : 1u;
}
DEV void xcd_barrier(const XcdBarrier& b) {
    asm volatile("s_waitcnt vmcnt(0)" ::: "memory");
    __syncthreads();
    if (threadIdx.x == 0) {
        unsigned* bar = b.bar;
        __builtin_amdgcn_s_waitcnt(0);
        unsigned nloc = b.st[0], nx = b.st[1];
        if (nloc == 0u) { xcd_barrier_complete(bar, b.x, nloc, nx); b.st[0] = nloc; b.st[1] = nx; }
        const unsigned old = xb_add(&bar[XB_XSUB(b.x)], 1u);
        const unsigned gen = old / nloc;
        if (old + 1u == (gen + 1u) * nloc) {
            __builtin_amdgcn_fence(__ATOMIC_RELEASE, "agent");
            asm volatile("s_waitcnt vmcnt(0)" ::: "memory");
            const unsigned og = xb_add(&bar[XB_TOP], 1u);
            const unsigned tg = og / nx;
            if (og + 1u == (tg + 1u) * nx) xb_add(&bar[XB_TOPGEN], 1u);
            else XB_SPIN(xb_ld(&bar[XB_TOPGEN]) == tg, bar);
            __builtin_amdgcn_fence(__ATOMIC_ACQUIRE, "agent");
            xb_add(&bar[XB_XGEN(b.x)], 1u);
            asm volatile("s_waitcnt vmcnt(0)" ::: "memory");
        } else {
            XB_SPIN(xb_ld(&bar[XB_XGEN(b.x)]) == gen, bar);
            __builtin_amdgcn_fence(__ATOMIC_ACQUIRE, "agent");
            asm volatile("s_waitcnt vmcnt(0)" ::: "memory");
        }
    }
    __syncthreads();
}

typedef const __attribute__((address_space(4))) Params* KParams;
__global__ void __launch_bounds__(512, 2) fwd_mega(Params p_unused) {
    extern __shared__ __attribute__((aligned(16))) unsigned char lds_raw[];
    LAS unsigned char* lds = (LAS unsigned char*)lds_raw;
    { volatile LAS unsigned* st = (volatile LAS unsigned*)(lds + 131072); if (threadIdx.x < 4) st[threadIdx.x] = 0u; }
    __syncthreads();
    KParams kp0 = (KParams)__builtin_amdgcn_kernarg_segment_ptr();
    XcdBarrier xbar = xcd_barrier_post((unsigned*)(kp0->ws + WS_BAR), (volatile LAS unsigned*)(lds + 131072));
    const int ph_lo = kp0->ph_lo, ph_hi = kp0->ph_hi;

    for (int ph = ph_lo; ph < ph_hi; ++ph) {
        KParams kp = (KParams)__builtin_amdgcn_kernarg_segment_ptr(); OPQS(kp);
        struct { KParams k; DEV const float* operator[](int i) const { return k->in[i]; } } pin{kp};
        unsigned char* ws = kp->ws;
        bf16_t* WIN = (bf16_t*)(ws + WS_WIN); bf16_t* WBR = (bf16_t*)(ws + WS_WBR); bf16_t* WO = (bf16_t*)(ws + WS_WO); bf16_t* WUP = (bf16_t*)(ws + WS_WUP);
        bf16_t* WDN = (bf16_t*)(ws + WS_WDN); bf16_t* W1T = (bf16_t*)(ws + WS_W1T); bf16_t* W2T = (bf16_t*)(ws + WS_W2T);
        bf16_t* KC = (bf16_t*)(ws + WS_KC); bf16_t* VC = (bf16_t*)(ws + WS_VC); bf16_t* H = (bf16_t*)(ws + WS_H); bf16_t* P = (bf16_t*)(ws + WS_P);
        bf16_t* O3 = (bf16_t*)(ws + WS_O3);
        bf16_t* OA = O3; bf16_t* OB = O3 + (size_t)T_ * 1024; bf16_t* OC = O3 + (size_t)2 * T_ * 1024;
        bf16_t* X = (bf16_t*)(ws + WS_X); float* OUT = kp->out;
        const int G = gridDim.x, c = blockIdx.x;
        if (ph == NPHASE - 1) {
            if (PHON(10)) phase_rmsnorm(nullptr, X, pin[20], nullptr, nullptr, OUT);
        } else {
            const int l = ph / 10, k = ph % 10;
            if (k == 0) { if (PHON(0)) {
                if (l == 0 && blockIdx.x == 0 && threadIdx.x < 4) ((int*)(ws + WS_MF))[threadIdx.x * 64] = 0;
                convT<128>(lds, pin[3] + (size_t)l * 1024 * NIN, 1024, NIN, WIN, NP, 1, 0);
                convT<128>(lds, pin[12] + (size_t)l * 1024 * 1024, 1024, 1024, WBR, 1024, 0, 192);
                convT<128>(lds, pin[13] + (size_t)l * 1024 * 1024, 1024, 1024, WBR + (size_t)1024 * 1024, 1024, 0, 192);
                convT<128>(lds, pin[14] + (size_t)l * 1024 * 1024, 1024, 1024, WBR + (size_t)2048 * 1024, 1024, 0, 192);
                convT<128>(lds, pin[15] + (size_t)l * 1024 * 1024, 1024, 1024, WO, 1024, 0, 192);
                convT<128>(lds, pin[17] + (size_t)l * 1024 * 6144, 1024, 6144, WUP, 6144, 2, 192);
                convT<128>(lds, pin[19] + (size_t)l * 3072 * 1024, 3072, 1024, WDN, 1024, 0, 192);
                convT<128>(lds, pin[6] + (size_t)(l * 2 + 0) * 2048 * 128, 2048, 128, W1T, 128, 0, 0);
                convT<128>(lds, pin[6] + (size_t)(l * 2 + 1) * 2048 * 128, 2048, 128, W1T + (size_t)128 * 2048, 128, 0, 64);
                convT<64>(lds, pin[7] + (size_t)(l * 2 + 0) * 128 * 64, 128, 64, W2T, 64, 0, 128);
                convT<64>(lds, pin[7] + (size_t)(l * 2 + 1) * 128 * 64, 128, 64, W2T + (size_t)64 * 128, 64, 0, 130);
                phase_rmsnorm(l == 0 ? pin[0] : nullptr, X, pin[2] + l * 1024, H, l == 0 ? X : nullptr, nullptr); }
            } else if (k == 1) { if (PHON(1)) {
                pg8::Gemm g{H, WIN, T_, NP, 1024}; pg8::StaticOrder S; S.init(T_, NP, G, c); pg8::EpiProj E{P, NP, 0, (bf16_t*)(ws + WS_KV), OA, (bf16_t*)(ws + WS_QB), pin[4] + (size_t)l * 3 * 1024, (float*)(ws + WS_GLA), (float*)(ws + WS_GFA), lds + LDS_EX};
                pg8::gemm_phase(lds, g, S, E); }
            } else if (k == 2) { if (PHON(2)) {
                phase_compress(lds, (const bf16_t*)(ws + WS_KV), pin[5] + (size_t)l * 2 * 2048, W1T, W2T, KC, VC);
                phase_rowpass(P, pin[4] + (size_t)l * 3 * 1024, pin[10] + l * 1024, pin[11] + l * 1024, OA, H  , (const float*)(ws + WS_GLA), (const float*)(ws + WS_GFA)); }
            } else if (k == 3) { if (PHON(3)) {
                if (PHON(11)) phase_mix(lds, P, (const bf16_t*)(ws + WS_QB), (const bf16_t*)(ws + WS_KV), KC, VC, pin[1], OB, H  , pin[8] + (size_t)l * 8 * 128 * 128, pin[9] + (size_t)l * 8 * 128, OC, (int*)(ws + WS_MF) + l * 64); }
            } else if (k == 4) { if (PHON(4)) {
                pg8::Gemm g{O3, WBR, 3 * T_, 3072, 1024}; pg8::BranchOrder S; S.init(G, c); pg8::EpiBranch E{P, H  };
                pg8::gemm_phase(lds, g, S, E); }
            } else if (k == 5) { if (PHON(5)) {
                pg8::Gemm g{H  , WO, T_, 1024, 1024}; pg8::StaticOrder S; S.init(T_, 1024, G, c); pg8::EpiRes E{X};
                pg8::gemm_phase(lds, g, S, E); }
            } else if (k == 6) { if (PHON(6)) {
                phase_rmsnorm(nullptr, X, pin[16] + l * 1024, H, nullptr, nullptr); }
            } else if (k == 7) { if (PHON(7)) {
                pg8::Gemm g{H, WUP, T_, 6144, 1024}; pg8::StaticOrder S; S.init(T_, 6144, G, c);
                pg8::EpiAct E{O3  , pin[18] + (size_t)l * 3 * DFF, (float*)(ws + WS_GL), (float*)(ws + WS_GF), lds + LDS_EX};
                pg8::gemm_phase(lds, g, S, E); }
            } else if (k == 8) {
                continue;
            } else { if (PHON(9)) {
                pg8::Gemm g{O3  , WDN, T_, 1024, 3072}; pg8::StaticOrder S; S.init(T_, 1024, G, c); pg8::EpiRes E{X};
                for (int i = 0;; ++i) { pg8::Unit uu; if (!S.next(i, uu)) break;
                    phase_actfix((const float*)(ws + WS_GL), (const float*)(ws + WS_GF), pin[18] + (size_t)l * 3 * DFF, O3  , uu.pm, 1); }
                asm volatile("s_waitcnt vmcnt(0)" ::: "memory"); __syncthreads();
                pg8::gemm_phase(lds, g, S, E); }
            }
        }
        if (ph + 1 < ph_hi) { if (ph == ph_lo) cg::this_grid().sync(); else xcd_barrier(xbar); }
    }
}

extern "C" void kernel_launch(void* const* d_in, const int* in_sizes, int n_in, void* d_out, int out_size, void* d_ws, size_t ws_size, hipStream_t stream) {
    static int grid = 0;
    if (grid == 0) {
        if (n_in != 21 || out_size != T_ * 1024 || ws_size < WS_END) { fprintf(stderr, "kernel_launch: unexpected shapes (n_in %d out %d ws %zu need %zu)\n", n_in, out_size, ws_size, (size_t)WS_END); grid = -1; return; }
        int dev = 0, cus = 0, per_cu = 0;
        hipGetDevice(&dev); hipDeviceGetAttribute(&cus, hipDeviceAttributeMultiprocessorCount, dev);
        hipFuncSetAttribute((const void*)fwd_mega, hipFuncAttributeMaxDynamicSharedMemorySize, LDS_BYTES);
        hipOccupancyMaxActiveBlocksPerMultiprocessor(&per_cu, (const void*)fwd_mega, 512, LDS_BYTES);
        if (per_cu < 1) { fprintf(stderr, "kernel_launch: occupancy query says %d blocks per CU\n", per_cu); per_cu = 1; }
        (void)hipGetLastError();
        grid = cus;
    }
    if (grid < 0) return;
    if (hipMemsetAsync((char*)d_ws + WS_BAR, 0, XCD_BAR_WORDS * 4, stream) != hipSuccess) { fprintf(stderr, "kernel_launch: memset of the barrier words failed\n"); return; }
    Params p{};
    for (int i = 0; i < 21; ++i) p.in[i] = (const float*)d_in[i];
    p.out = (float*)d_out; p.ws = (unsigned char*)d_ws;
#if PER_PHASE_LAUNCH
    for (int ph = 0; ph < NPHASE; ++ph) { p.ph_lo = ph; p.ph_hi = ph + 1; hipLaunchKernelGGL(fwd_mega, dim3(grid), dim3(512), LDS_BYTES, stream, p); }
#else
    p.ph_lo = 0; p.ph_hi = NPHASE;
    void* args[] = {&p};
    hipError_t e = hipLaunchCooperativeKernel((const void*)fwd_mega, dim3(grid), dim3(512), args, LDS_BYTES, stream);
    if (e != hipSuccess) fprintf(stderr, "cooperative launch failed: %s (grid %d)\n", hipGetErrorString(e), grid);
#endif
}
```

```cpp
#include <hip/hip_runtime.h>
#include <hip/hip_cooperative_groups.h>
#include <cstdio>
namespace cg = cooperative_groups;

#ifndef PHASE_MASK
#define PHASE_MASK 0x1fff
#endif
#define PHON(k) ((PHASE_MASK >> (k)) & 1)
#ifndef PER_PHASE_LAUNCH
#define PER_PHASE_LAUNCH 0
#endif

#define LAS __attribute__((address_space(3)))
#define DEV __device__ __forceinline__
#define OPQV(x) asm volatile("" : "+v"(x))
#define OPQS(x) asm volatile("" : "+s"(x))
typedef unsigned short bf16_t;
typedef short bf16x8 __attribute__((ext_vector_type(8)));
typedef float f32x4 __attribute__((ext_vector_type(4)));
typedef unsigned u32x4 __attribute__((ext_vector_type(4)));
typedef unsigned u32x2 __attribute__((ext_vector_type(2)));

constexpr int T_ = 16384, S_ = 2048, NP = 11008, NIN = 10800, DFF = 3072;
constexpr int COL_GB = 0, COL_GC = 1024, COL_VA = 2048, COL_Q = 3072, COL_KC = 4096, COL_VC = 4352, COL_KS = 4608, COL_VS = 4864,
              COL_KW = 5120, COL_VW = 5376, COL_U = 5632, COL_V = 6656, COL_G0 = 7680, COL_GN = 10752;
constexpr float EPS_ = 1e-6f, SCALE_ = 0.125f, NEG_ = -1e30f, LOG2E_ = 1.4426950408889634f, QSC_ = 0.125f * 1.4426950408889634f;
constexpr int LDS_EX = 131072 + 16;
constexpr int LDS_BYTES = 131072 + 16 + 1024;
constexpr int NPHASE = 41;

constexpr size_t WS_WIN = 0;
constexpr size_t WS_WBR = WS_WIN + (size_t)NP * 1024 * 2;
constexpr size_t WS_WO = WS_WBR + (size_t)3072 * 1024 * 2;
constexpr size_t WS_WUP = WS_WO + (size_t)1024 * 1024 * 2;
constexpr size_t WS_WDN = WS_WUP + (size_t)6144 * 1024 * 2;
constexpr size_t WS_W1T = WS_WDN + (size_t)1024 * 3072 * 2;
constexpr size_t WS_W2T = WS_W1T + (size_t)2 * 128 * 2048 * 2;
constexpr size_t WS_KC = WS_W2T + (size_t)2 * 64 * 128 * 2;
constexpr size_t WS_VC = WS_KC + (size_t)32 * 128 * 64 * 2;
constexpr size_t WS_H = WS_VC + (size_t)32 * 128 * 64 * 2;
constexpr size_t WS_P = WS_H + (size_t)T_ * 1024 * 2;
constexpr size_t WS_O3 = WS_P + (size_t)T_ * NP * 2;
constexpr size_t WS_MF = WS_O3 + (size_t)3 * T_ * 1024 * 2;
constexpr size_t WS_KV = WS_MF + 4096;
constexpr size_t WS_X = WS_MF + (size_t)T_ * 1024 * 4;
constexpr size_t WS_QB = WS_X + (size_t)T_ * 1024 * 2;
constexpr size_t WS_GLA = WS_QB + (size_t)T_ * 1024 * 2;
constexpr size_t WS_GFA = WS_GLA + (size_t)64 * 2 * 1024 * 4;
constexpr size_t WS_END = WS_GFA + (size_t)64 * 2 * 2 * 1024 * 4;
constexpr size_t WS_BAR = WS_MF + (size_t)60 * 1048576;
constexpr size_t WS_GL = WS_MF + (size_t)52 * 1048576;
constexpr size_t WS_GF = WS_GL + (size_t)64 * 2 * DFF * 4;
constexpr size_t KV_TENSOR = (size_t)8 * 4 * S_ * 64;

struct Params { const float* in[21]; float* out; unsigned char* ws; int ph_lo, ph_hi; };

DEV float bf2f(unsigned b) { return __uint_as_float(b << 16); }
DEV float bflo(unsigned u) { return __uint_as_float(u << 16); }
DEV float bfhi(unsigned u) { return __uint_as_float(u & 0xffff0000u); }
DEV unsigned cvt_pk_bf16(float lo, float hi) { unsigned r; asm volatile("v_cvt_pk_bf16_f32 %0, %1, %2" : "=v"(r) : "v"(lo), "v"(hi)); return r; }
DEV float gelu_t(float x) { const float u = x * (0.7978845608f + 0.0356774081f * x * x); return x * __builtin_amdgcn_rcpf(1.f + __builtin_amdgcn_exp2f(-2.885390082f * u)); }
DEV float sigm(float x) { return __builtin_amdgcn_rcpf(1.f + __builtin_amdgcn_exp2f(-1.4426950409f * x)); }
DEV void unpack8(const u32x4 v, float (&f)[8]) { f[0] = bflo(v.x); f[1] = bfhi(v.x); f[2] = bflo(v.y); f[3] = bfhi(v.y); f[4] = bflo(v.z); f[5] = bfhi(v.z); f[6] = bflo(v.w); f[7] = bfhi(v.w); }
DEV u32x4 pack8(const float (&f)[8]) { u32x4 w; w.x = cvt_pk_bf16(f[0], f[1]); w.y = cvt_pk_bf16(f[2], f[3]); w.z = cvt_pk_bf16(f[4], f[5]); w.w = cvt_pk_bf16(f[6], f[7]); return w; }
DEV u32x4 pair32(u32x2 a, u32x2 b) {
    const auto r0 = __builtin_amdgcn_permlane32_swap(a.x, b.x, false, false); const auto r1 = __builtin_amdgcn_permlane32_swap(a.y, b.y, false, false);
    return (u32x4){r0[0], r1[0], r0[1], r1[1]};
}
DEV bf16x8 as_bf16x8(u32x4 v) { union { u32x4 u; bf16x8 b; } x; x.u = v; return x.b; }

namespace pg8 {
constexpr int BM = 256, BK = 64, HALF = 128, HTB = HALF * BK * 2, NXCD = 8, WGM = 8;
DEV int lds_byte(int r, int c) { const int st = (r >> 4) * 2 + (c >> 5), rr = r & 15, cc = c & 31, ob = rr * 64 + cc * 2; return st * 1024 + (ob ^ (((ob >> 9) & 1) << 5)); }
DEV void stage_rc(int b, int& R, int& C) { const int st = b / 1024, sb = b % 1024, swz = sb ^ (((sb >> 9) & 1) << 5); R = (st >> 1) * 16 + swz / 64; C = (st & 1) * 32 + (swz % 64) / 2; }
DEV int perm32(int rho) { const int n = rho >> 4, i = rho & 15; return 8 * (i >> 2) + 4 * n + (i & 3); }
struct Unit { int pm, pn; };
struct Gemm { const bf16_t* A; const bf16_t* Bt; int M, N, K; };

struct StaticOrder {
    int nM, nN, nwg, G, c;
    DEV void init(int M, int N, int G_, int c_) { nM = M / BM; nN = N / BM; nwg = nM * nN; G = G_; c = c_; }
    DEV bool tile(long L, Unit& u) const {
        if (L >= nwg) return false;
        int wgid = (int)L; { const int q = nwg / NXCD, r = nwg % NXCD, xcd = wgid % NXCD, off = wgid / NXCD; wgid = (xcd < r ? xcd * (q + 1) : r * (q + 1) + (xcd - r) * q) + off; }
        const int nig = WGM * nN, gid = wgid / nig, fm = gid * WGM, gsz = (nM - fm) < WGM ? (nM - fm) : WGM;
        u.pm = fm + ((wgid % nig) % gsz); u.pn = (wgid % nig) / gsz; return true;
    }
    DEV bool next(int i, Unit& u) const { return tile((long)i * G + c, u); }
};
struct BranchOrder {
    StaticOrder so;
    DEV void init(int G_, int c_) { so.init(T_, 1024, G_, c_); }
    DEV bool next(int i, Unit& u) const { const int round = i / 3, br = i - round * 3; Unit t; if (!so.tile((long)round * so.G + so.c, t)) return false; u.pm = br * 64 + t.pm; u.pn = br * 4 + t.pn; return true; }
};

struct EpiProj {
    static constexpr bool PERM = true, ROWPERM = true;
    bf16_t* O; int ldc; int act_mode; bf16_t* KV; bf16_t* OA; bf16_t* QB; const float* cwa; float* GLA; float* GFA; LAS unsigned char* ex;
    DEV bool operator()(f32x4 (&acc)[2][2][4][2], const Unit& u, int wr, int wc, int fr, int fq) const {
        const int row0 = u.pm * BM + (16 * wr + fr) * 8, col0 = u.pn * BM + wc * 32 + 8 * fq;
        const int act = act_mode ? 0 : (u.pn < 22 ? 0 : (u.pn < 26 ? 1 : 2));
        const bool kvt = !act_mode && u.pn >= 16 && u.pn < 22;
        if (!act_mode && u.pn >= 26 && u.pn < 42) {
            const int chb = (u.pn - 26) * 64 + wc * 16 + (fq & 1) * 8, up = fq >> 1;
#pragma unroll
            for (int ai = 0; ai < 2; ++ai)
#pragma unroll
                for (int mp = 0; mp < 2; ++mp) { u32x2 pk[2][4];
#pragma unroll
                    for (int mm = 0; mm < 2; ++mm) { const int m = mp * 2 + mm; float f0[4], f1[4], f2[4], uu[4];
#pragma unroll
                        for (int j = 0; j < 4; ++j) { const float s0 = sigm(acc[ai][0][m][0][j]), s1 = fmaxf(sigm(acc[ai][0][m][1][j]), 1e-12f), s2 = fmaxf(sigm(acc[ai][1][m][0][j]), 1e-12f);
                            f0[j] = s0 * __builtin_amdgcn_rcpf(s1); f1[j] = s1 * __builtin_amdgcn_rcpf(s2); f2[j] = s2; uu[j] = gelu_t(acc[ai][1][m][1][j]); }
                        pk[mm][0].x = cvt_pk_bf16(f0[0], f0[1]); pk[mm][0].y = cvt_pk_bf16(f0[2], f0[3]); pk[mm][1].x = cvt_pk_bf16(f1[0], f1[1]); pk[mm][1].y = cvt_pk_bf16(f1[2], f1[3]);
                        pk[mm][2].x = cvt_pk_bf16(f2[0], f2[1]); pk[mm][2].y = cvt_pk_bf16(f2[2], f2[3]); pk[mm][3].x = cvt_pk_bf16(uu[0], uu[1]); pk[mm][3].y = cvt_pk_bf16(uu[2], uu[3]); }
                    bf16_t* rp = O + (size_t)(row0 + ai * 4 + mp * 2 + up) * ldc + chb;
                    *(u32x4*)(rp + COL_G0) = pair32(pk[0][0], pk[1][0]);
                    *(u32x4*)(rp + COL_G0 + 1024) = pair32(pk[0][1], pk[1][1]);
                    *(u32x4*)(rp + COL_G0 + 2048) = pair32(pk[0][2], pk[1][2]);
                    *(u32x4*)(rp + COL_U) = pair32(pk[0][3], pk[1][3]); }
            return true;
        }
        if (!act_mode && u.pn < 16) {
            const int ch0 = u.pn * 64 + wc * 16 + (fq & 1) * 8 + (fq >> 1) * 4, chb = u.pn * 64 + wc * 16 + (fq & 1) * 8, up = fq >> 1;
            f32x4 w[3];
#pragma unroll
            for (int k = 0; k < 3; ++k) w[k] = *(const f32x4*)(cwa + k * 1024 + ch0);
            f32x4 xp[8];
#pragma unroll
            for (int i = 0; i < 8; ++i) xp[i] = acc[i >> 2][0][i & 3][1] * acc[i >> 2][1][i & 3][0];
            f32x4 p6, p7;
#pragma unroll
            for (int c = 0; c < 4; ++c) { p6[c] = __shfl_up(xp[6][c], 1); p7[c] = __shfl_up(xp[7][c], 1); }
            LAS f32x4* EX = (LAS f32x4*)ex + (wc * 4 + fq) * 2;
            if (wr == 0 && fr == 15) { EX[0] = xp[6]; EX[1] = xp[7]; asm volatile("s_waitcnt lgkmcnt(0)" ::: "memory"); }
            if (wr == 1 && fr == 0) { p6 = EX[0]; p7 = EX[1]; }
            if (wr == 1 && fr == 15) { float* gl = GLA + (size_t)u.pm * 2 * 1024 + ch0; *(f32x4*)gl = xp[6]; *(f32x4*)(gl + 1024) = xp[7]; }
            const bool halo = (wr == 0 && fr == 0);
            if (halo) {
#pragma unroll
                for (int t = 0; t < 2; ++t) { float* gf = GFA + ((size_t)(u.pm * 2 + t) * 2) * 1024 + ch0; *(f32x4*)gf = acc[0][0][t][0]; *(f32x4*)(gf + 1024) = xp[t]; } }
#pragma unroll
            for (int ip = 0; ip < 4; ++ip) { u32x2 o[2], q2[2];
#pragma unroll
                for (int ii = 0; ii < 2; ++ii) { const int i = ip * 2 + ii;
                    const f32x4 xm1 = i >= 1 ? xp[i >= 1 ? i - 1 : 0] : p7, xm2 = i >= 2 ? xp[i >= 2 ? i - 2 : 0] : (i == 0 ? p6 : p7);
                    const f32x4 y = acc[i >> 2][0][i & 3][0] * (w[0] * xm2 + w[1] * xm1 + w[2] * xp[i]);
                    o[ii].x = cvt_pk_bf16(y[0], y[1]); o[ii].y = cvt_pk_bf16(y[2], y[3]);
                    const f32x4 qv = acc[i >> 2][1][i & 3][1];
                    q2[ii].x = cvt_pk_bf16(qv[0], qv[1]); q2[ii].y = cvt_pk_bf16(qv[2], qv[3]); }
                const size_t tok = (size_t)(row0 + ip * 2 + up);
                const u32x4 ow = pair32(o[0], o[1]), qw = pair32(q2[0], q2[1]);
                if (!(halo && ip == 0)) *(u32x4*)(OA + tok * 1024 + chb) = ow;
                *(u32x4*)(QB + tok * 1024 + chb) = qw; }
            return true;
        }
#pragma unroll
        for (int ai = 0; ai < 2; ++ai)
#pragma unroll
            for (int m = 0; m < 4; ++m) { const int row = row0 + ai * 4 + m; bf16_t* rowp = O + (size_t)row * ldc + col0 + ((!act_mode && u.pn >= 22 && u.pn < 26) ? 1024 : 0);
                if (kvt) rowp = KV + (size_t)(u.pn - 16) * KV_TENSOR + ((size_t)((row >> 11) * 4) * S_ + (row & (S_ - 1))) * 64 + (size_t)(wc >> 1) * S_ * 64 + (wc & 1) * 32 + 8 * fq;
#pragma unroll
                for (int bj = 0; bj < 2; ++bj) { float v[8];
#pragma unroll
                    for (int j = 0; j < 4; ++j) { v[j] = acc[ai][bj][m][0][j]; v[4 + j] = acc[ai][bj][m][1][j]; }
                    if (act == 1) {
#pragma unroll
                        for (int j = 0; j < 8; ++j) v[j] = gelu_t(v[j]); }
                    else if (act == 2) {
#pragma unroll
                        for (int j = 0; j < 8; ++j) v[j] = sigm(v[j]); }
                    *(u32x4*)(rowp + (kvt ? (size_t)bj * 2 * S_ * 64 : (size_t)bj * HALF)) = pack8(v); } }
        return true;
    }
};
struct EpiBranch {
    static constexpr bool PERM = true, ROWPERM = false;
    const bf16_t* P; bf16_t* MB;
    DEV bool operator()(f32x4 (&acc)[2][2][4][2], const Unit& u, int wr, int wc, int fr, int fq) const {
        const int br = u.pn >> 2, pn = u.pn & 3, pm = u.pm - br * 64;
        const int row0 = pm * BM + wr * 64 + fr, col0 = pn * BM + wc * 32 + 8 * fq;
#pragma unroll
        for (int ai = 0; ai < 2; ++ai) {
            u32x4 ga[4][2];
#pragma unroll
            for (int m = 0; m < 4; ++m)
#pragma unroll
                for (int bj = 0; bj < 2; ++bj) ga[m][bj] = *(const u32x4*)(P + (size_t)(row0 + ai * HALF + m * 16) * NP + COL_G0 + br * 1024 + col0 + bj * HALF);
#pragma unroll
            for (int m = 0; m < 4; ++m)
#pragma unroll
                for (int bj = 0; bj < 2; ++bj) { const size_t row = (size_t)(row0 + ai * HALF + m * 16);
                    float f[8], v[8]; unpack8(ga[m][bj], f);
#pragma unroll
                    for (int j = 0; j < 4; ++j) { v[j] = acc[ai][bj][m][0][j] * f[j]; v[4 + j] = acc[ai][bj][m][1][j] * f[4 + j]; }
                    if (br < 2) { acc[ai][bj][m][0] = (f32x4){v[0], v[1], v[2], v[3]}; acc[ai][bj][m][1] = (f32x4){v[4], v[5], v[6], v[7]}; }
                    else *(u32x4*)(MB + row * 1024 + col0 + bj * HALF) = pack8(v); }
        }
        return br == 2;
    }
};
struct EpiRes {
    static constexpr bool PERM = true, ROWPERM = false;
    bf16_t* X;
    DEV bool operator()(f32x4 (&acc)[2][2][4][2], const Unit& u, int wr, int wc, int fr, int fq) const {
        const int row0 = u.pm * BM + wr * 64 + fr, col0 = u.pn * BM + wc * 32 + 8 * fq;
#pragma unroll
        for (int ai = 0; ai < 2; ++ai) {
            u32x4 old[4][2];
#pragma unroll
            for (int m = 0; m < 4; ++m)
#pragma unroll
                for (int bj = 0; bj < 2; ++bj) old[m][bj] = *(const u32x4*)(X + (size_t)(row0 + ai * HALF + m * 16) * 1024 + col0 + bj * HALF);
#pragma unroll
            for (int m = 0; m < 4; ++m)
#pragma unroll
                for (int bj = 0; bj < 2; ++bj) { float v[8]; unpack8(old[m][bj], v);
#pragma unroll
                    for (int j = 0; j < 4; ++j) { v[j] += acc[ai][bj][m][0][j]; v[4 + j] += acc[ai][bj][m][1][j]; }
                    *(u32x4*)(X + (size_t)(row0 + ai * HALF + m * 16) * 1024 + col0 + bj * HALF) = pack8(v); }
        }
        return true;
    }
};
struct EpiAct {
    static constexpr bool PERM = true, ROWPERM = true;
    bf16_t* ACT; const float* cw; float* GL; float* GF; LAS unsigned char* ex;
    DEV bool operator()(f32x4 (&acc)[2][2][4][2], const Unit& u, int wr, int wc, int fr, int fq) const {
        const int ch0 = u.pn * 128 + wc * 32 + 8 * fq;
        float w[3][8];
#pragma unroll
        for (int k = 0; k < 3; ++k) { const f32x4 w0 = *(const f32x4*)(cw + k * DFF + ch0), w1 = *(const f32x4*)(cw + k * DFF + ch0 + 4);
#pragma unroll
            for (int j = 0; j < 4; ++j) { w[k][j] = w0[j]; w[k][4 + j] = w1[j]; } }
        float p6[8], p7[8];
#pragma unroll
        for (int c = 0; c < 8; ++c) { p6[c] = __shfl_up(acc[1][0][2][c >> 2][c & 3], 1); p7[c] = __shfl_up(acc[1][0][3][c >> 2][c & 3], 1); }
        LAS float* EX = (LAS float*)ex + (wc * 4 + fq) * 16;
        if (wr == 0 && fr == 15) {
#pragma unroll
            for (int c = 0; c < 8; ++c) { EX[c] = acc[1][0][2][c >> 2][c & 3]; EX[8 + c] = acc[1][0][3][c >> 2][c & 3]; }
            asm volatile("s_waitcnt lgkmcnt(0)" ::: "memory");
        }
        if (wr == 1 && fr == 0) {
#pragma unroll
            for (int c = 0; c < 8; ++c) { p6[c] = EX[c]; p7[c] = EX[8 + c]; } }
        if (wr == 1 && fr == 15) { float* gl = GL + (size_t)u.pm * 2 * DFF + ch0;
            *(f32x4*)gl = acc[1][0][2][0]; *(f32x4*)(gl + 4) = acc[1][0][2][1]; *(f32x4*)(gl + DFF) = acc[1][0][3][0]; *(f32x4*)(gl + DFF + 4) = acc[1][0][3][1]; }
        const bool halo = (wr == 0 && fr == 0);
        if (halo) {
#pragma unroll
            for (int t = 0; t < 2; ++t) { float* gf = GF + ((size_t)(u.pm * 2 + t) * 2) * DFF + ch0;
                *(f32x4*)gf = acc[0][0][t][0]; *(f32x4*)(gf + 4) = acc[0][0][t][1]; *(f32x4*)(gf + DFF) = acc[0][1][t][0]; *(f32x4*)(gf + DFF + 4) = acc[0][1][t][1]; } }
        bf16_t* outp = ACT + ((size_t)u.pm * BM + (size_t)(16 * wr + fr) * 8) * DFF + ch0;
#pragma unroll
        for (int i = 0; i < 8; ++i) { float y[8];
#pragma unroll
            for (int c = 0; c < 8; ++c) {
                const float g0 = acc[i >> 2][0][i & 3][c >> 2][c & 3];
                const float gm1 = i >= 1 ? acc[(i - 1 < 0 ? 0 : i - 1) >> 2][0][(i - 1 < 0 ? 0 : i - 1) & 3][c >> 2][c & 3] : p7[c];
                const float gm2 = i >= 2 ? acc[(i - 2 < 0 ? 0 : i - 2) >> 2][0][(i - 2 < 0 ? 0 : i - 2) & 3][c >> 2][c & 3] : (i == 0 ? p6[c] : p7[c]);
                y[c] = gelu_t(w[0][c] * gm2 + w[1][c] * gm1 + w[2][c] * g0) * acc[i >> 2][1][i & 3][c >> 2][c & 3]; }
            if (!(halo && i < 2)) *(u32x4*)(outp + (size_t)i * DFF) = pack8(y); }
        return true;
    }
};

template <class Epi, class Sched>
DEV void gemm_phase(LAS unsigned char* lds, const Gemm g, const Sched& S, const Epi& E) {
    int tid = threadIdx.x; OPQV(tid);
    const int wid = __builtin_amdgcn_readfirstlane(tid >> 6), lane = tid & 63, wr = wid >> 2, wc = wid & 3, fr = lane & 15, fq = lane >> 4;
    const int K = g.K, nt = K / BK;
    unsigned voffA[2], voffB[2];
#pragma unroll
    for (int i = 0; i < 2; ++i) { int R, C; stage_rc(tid * 16 + i * 8192, R, C); const int Rb = Epi::PERM ? ((R & ~31) + perm32(R & 31)) : R;
        const int Ra = Epi::ROWPERM ? (((R >> 6) * 16 + (R & 15)) * 8 + ((R >> 4) & 3)) : R;
        voffA[i] = (unsigned)(Ra * K + C) * 2u; voffB[i] = (unsigned)(Rb * K + C) * 2u; }
    const size_t kstep = (size_t)(BK * 2);
    const size_t hstep = (size_t)HALF * K * 2;
    const size_t hstepA = Epi::ROWPERM ? (size_t)4 * K * 2 : hstep;
    const size_t tstep = 2 * hstep;
    const unsigned ldsw = (unsigned)wid * 1024u;
    const int aoff = lds_byte(wr * 64 + fr, fq * 8), boff = lds_byte(wc * 32 + fr, fq * 8);
#define PG8_SA(b, h) (((b) * 2 + (h)) * HTB)
#define PG8_SB(b, h) ((4 + (b) * 2 + (h)) * HTB)
#define PG8_STAGE(bufoff, gbase, voff) do { _Pragma("unroll") for (int _i = 0; _i < 2; ++_i) \
        __builtin_amdgcn_global_load_lds((const unsigned*)((const char*)(gbase) + (voff)[_i]), (LAS unsigned*)(lds + (bufoff) + ldsw + _i * 8192), 16, 0, 0); } while (0)
#define PG8_LDA(dst, b, h) do { _Pragma("unroll") for (int m = 0; m < 4; ++m) _Pragma("unroll") for (int k = 0; k < 2; ++k) dst[m][k] = *(const LAS bf16x8*)(lds + PG8_SA(b, h) + aoff + m * 2048 + k * 1024); } while (0)
#define PG8_LDB(dst, b, h) do { _Pragma("unroll") for (int n = 0; n < 2; ++n) _Pragma("unroll") for (int k = 0; k < 2; ++k) dst[n][k] = *(const LAS bf16x8*)(lds + PG8_SB(b, h) + boff + n * 2048 + k * 1024); } while (0)
#define PG8_MMA(ai, bj, At, Bt) do { __builtin_amdgcn_s_setprio(1); _Pragma("unroll") for (int m = 0; m < 4; ++m) _Pragma("unroll") for (int n = 0; n < 2; ++n) _Pragma("unroll") for (int k = 0; k < 2; ++k) \
        acc[ai][bj][m][n] = __builtin_amdgcn_mfma_f32_16x16x32_bf16(Bt[n][k], At[m][k], acc[ai][bj][m][n], 0, 0, 0); __builtin_amdgcn_s_setprio(0); } while (0)
#define PG8_WAIT_V(n) asm volatile("s_waitcnt vmcnt(" #n ")" ::: "memory")
#define PG8_WAIT_L(n) asm volatile("s_waitcnt lgkmcnt(" #n ")" ::: "memory")
#define PG8_BAR __builtin_amdgcn_s_barrier()
#define PG8_SCHED __builtin_amdgcn_sched_barrier(0)
    Unit cur, nxt; int ui = 0;
    if (!S.next(0, cur)) return;
    f32x4 acc[2][2][4][2];
#pragma unroll
    for (int a = 0; a < 2; ++a)
#pragma unroll
        for (int b = 0; b < 2; ++b)
#pragma unroll
            for (int m = 0; m < 4; ++m)
#pragma unroll
                for (int n = 0; n < 2; ++n) acc[a][b][m][n] = (f32x4){0.f, 0.f, 0.f, 0.f};
    bf16x8 At[4][2], B0[2][2], B1[2][2];
    const char* cA = (const char*)g.A + (size_t)cur.pm * tstep; const char* cB = (const char*)g.Bt + (size_t)cur.pn * tstep;
    PG8_STAGE(PG8_SB(0, 0), cB, voffB); PG8_STAGE(PG8_SA(0, 0), cA, voffA); PG8_STAGE(PG8_SB(0, 1), cB + hstep, voffB); PG8_STAGE(PG8_SA(0, 1), cA + hstepA, voffA);
    if (wr == 1) PG8_BAR;
    PG8_WAIT_V(4); PG8_BAR;
    PG8_STAGE(PG8_SB(1, 0), cB + kstep, voffB); PG8_STAGE(PG8_SA(1, 0), cA + kstep, voffA); PG8_STAGE(PG8_SB(1, 1), cB + hstep + kstep, voffB);
    PG8_WAIT_V(6); PG8_BAR;
    for (;;) {
        const bool has_next = S.next(ui + 1, nxt);
        const char* nA = has_next ? (const char*)g.A + (size_t)nxt.pm * tstep : cA; const char* nB = has_next ? (const char*)g.Bt + (size_t)nxt.pn * tstep : cB;
        asm volatile(".p2align 8" ::: "memory");
        for (int t = 0; t < nt; t += 2) {
            const bool last = (t == nt - 2);
            const char* a1 = cA + (size_t)(t + 1) * kstep;
            const char* a2 = last ? nA : cA + (size_t)(t + 2) * kstep; const char* b2 = last ? nB : cB + (size_t)(t + 2) * kstep;
            const char* a3 = a2 + kstep; const char* b3 = b2 + kstep;
            PG8_LDB(B0, 0, 0); PG8_SCHED; PG8_LDA(At, 0, 0); PG8_STAGE(PG8_SA(1, 1), a1 + hstepA, voffA);
            PG8_WAIT_L(8); PG8_BAR; PG8_WAIT_L(0); PG8_MMA(0, 0, At, B0); PG8_BAR; PG8_SCHED;
            PG8_LDB(B1, 0, 1); PG8_STAGE(PG8_SB(0, 0), b2, voffB);
            PG8_BAR; PG8_WAIT_L(0); PG8_MMA(0, 1, At, B1); PG8_BAR;
            PG8_LDA(At, 0, 1); PG8_STAGE(PG8_SA(0, 0), a2, voffA);
            PG8_BAR; PG8_WAIT_L(0); PG8_MMA(1, 0, At, B0); PG8_BAR; PG8_SCHED;
            PG8_STAGE(PG8_SB(0, 1), b2 + hstep, voffB);
            PG8_WAIT_V(6); PG8_BAR; PG8_MMA(1, 1, At, B1); PG8_BAR;
            PG8_LDB(B0, 1, 0); PG8_SCHED; PG8_LDA(At, 1, 0); PG8_STAGE(PG8_SA(0, 1), a2 + hstepA, voffA);
            PG8_WAIT_L(8); PG8_BAR; PG8_WAIT_L(0); PG8_MMA(0, 0, At, B0); PG8_BAR; PG8_SCHED;
            PG8_LDB(B1, 1, 1); PG8_STAGE(PG8_SB(1, 0), b3, voffB);
            PG8_BAR; PG8_WAIT_L(0); PG8_MMA(0, 1, At, B1); PG8_BAR;
            PG8_LDA(At, 1, 1); PG8_STAGE(PG8_SA(1, 0), a3, voffA);
            PG8_BAR; PG8_WAIT_L(0); PG8_MMA(1, 0, At, B0); PG8_BAR; PG8_SCHED;
            PG8_STAGE(PG8_SB(1, 1), b3 + hstep, voffB);
            PG8_WAIT_V(6); PG8_BAR; PG8_MMA(1, 1, At, B1); PG8_BAR;
        }
        const bool rst = E(acc, cur, wr, wc, fr, fq);
        if (!has_next) break;
        if (rst) {
#pragma unroll
        for (int a = 0; a < 2; ++a)
#pragma unroll
            for (int b = 0; b < 2; ++b)
#pragma unroll
                for (int m = 0; m < 4; ++m)
#pragma unroll
                    for (int n = 0; n < 2; ++n) acc[a][b][m][n] = (f32x4){0.f, 0.f, 0.f, 0.f}; }
        cur = nxt; cA = nA; cB = nB; ++ui;
    }
    PG8_WAIT_V(0);
    if (wr == 0) PG8_BAR;
    PG8_BAR;
#undef PG8_SA
#undef PG8_SB
#undef PG8_STAGE
#undef PG8_LDA
#undef PG8_LDB
#undef PG8_MMA
#undef PG8_WAIT_V
#undef PG8_WAIT_L
#undef PG8_BAR
#undef PG8_SCHED
}
}

DEV int map_col(int n, int Nsrc, int mode) {
    if (mode == 1) { if (n < 4096) { const int U = n >> 8, c = n & 255; const int fq = (c >> 3) & 3; const int t = (c >> 7) * 2 + ((c >> 2) & 1), ch = 64 * U + ((c >> 5) & 3) * 16 + (fq & 1) * 8 + (fq >> 1) * 4 + (c & 3); return t * 1024 + ch; }
        if (n < 5632) return n;
        if (n < 6656) return 6704 + (n - 5632);
        if (n < 10752) { const int m = n - 6656, U = m >> 8, c = m & 255;
            const int fq = (c >> 3) & 3; const int t = (c >> 7) * 2 + ((c >> 2) & 1), ch = 64 * U + ((c >> 5) & 3) * 16 + (fq & 1) * 8 + (fq >> 1) * 4 + (c & 3);
            return (t == 0 ? 7728 : t == 1 ? 8752 : t == 2 ? 9776 : 5680) + ch; }
        if (n < 10800) return n - 5120; return -1; }
    if (mode == 2) { const int pn = n >> 8, r = n & 255; return r < 128 ? 128 * pn + r : 3072 + 128 * pn + (r - 128); }
    return n < Nsrc ? n : -1;
}
DEV void lds_barrier() { asm volatile("s_waitcnt lgkmcnt(0)" ::: "memory"); __builtin_amdgcn_s_barrier(); asm volatile("" ::: "memory"); }
template <int NW>
DEV void convT(LAS unsigned char* lds, const float* src, int K, int Nsrc, bf16_t* dst, int Npad, int mode, int rot) {
    LAS float* tile = (LAS float*)lds;
    int tid = threadIdx.x; OPQV(tid); const int G = gridDim.x;
    constexpr int PW = NW + 1, NL = NW * 64 / 512, RPI = 512 / NW, TPN = 512 / NW, KS = 64 / TPN;
    const int ntk = K / 64, ntn = Npad / NW, ntiles = ntk * ntn;
    const int n = tid % NW, kr = tid / NW;
    int tix = (blockIdx.x + G - (rot % G)) % G;
    float ld[NL];
    if (tix < ntiles) { const int n0 = (tix / ntk) * NW, k0 = (tix % ntk) * 64; const int sc = map_col(n0 + n, Nsrc, mode);
#pragma unroll
        for (int i = 0; i < NL; ++i) ld[i] = sc >= 0 ? __builtin_nontemporal_load(src + (size_t)(k0 + i * RPI + kr) * Nsrc + sc) : 0.f; }
    for (; tix < ntiles; tix += G) {
        const int n0 = (tix / ntk) * NW, k0 = (tix % ntk) * 64;
#pragma unroll
        for (int i = 0; i < NL; ++i) tile[(i * RPI + kr) * PW + n] = ld[i];
        lds_barrier();
        const int tnx = tix + G;
        if (tnx < ntiles) { const int n1 = (tnx / ntk) * NW, k1 = (tnx % ntk) * 64; const int sc = map_col(n1 + n, Nsrc, mode);
#pragma unroll
            for (int i = 0; i < NL; ++i) ld[i] = sc >= 0 ? __builtin_nontemporal_load(src + (size_t)(k1 + i * RPI + kr) * Nsrc + sc) : 0.f; }
        { const int nn = tid / TPN, ks = (tid % TPN) * KS;
#pragma unroll
            for (int h = 0; h < KS / 8; ++h) { float v[8];
#pragma unroll
                for (int j = 0; j < 8; ++j) v[j] = tile[(ks + h * 8 + j) * PW + nn];
                *(u32x4*)(dst + (size_t)(n0 + nn) * K + k0 + ks + h * 8) = pack8(v); } }
        lds_barrier();
    }
}
DEV float wave_sum(float v) {
#pragma unroll
    for (int o = 32; o >= 1; o >>= 1) v += __shfl_xor(v, o);
    return v;
}
template <int RB>
DEV void rmsnorm_rows(const float* srcf, const bf16_t* srcb, const float* gamma, bf16_t* H, bf16_t* cpy, float* outn, int row0, int lane) {
    float v[RB][16];
    if (srcf) {
#pragma unroll
        for (int r = 0; r < RB; ++r)
#pragma unroll
            for (int hf = 0; hf < 2; ++hf) { const f32x4 a = *(const f32x4*)(srcf + (size_t)(row0 + r) * 1024 + hf * 512 + lane * 8), b2 = *(const f32x4*)(srcf + (size_t)(row0 + r) * 1024 + hf * 512 + lane * 8 + 4);
#pragma unroll
                for (int j = 0; j < 4; ++j) { v[r][hf * 8 + j] = a[j]; v[r][hf * 8 + 4 + j] = b2[j]; } }
    } else {
        u32x4 raw[RB][2];
#pragma unroll
        for (int r = 0; r < RB; ++r)
#pragma unroll
            for (int hf = 0; hf < 2; ++hf) raw[r][hf] = *(const u32x4*)(srcb + (size_t)(row0 + r) * 1024 + hf * 512 + lane * 8);
#pragma unroll
        for (int r = 0; r < RB; ++r)
#pragma unroll
            for (int hf = 0; hf < 2; ++hf) { float t8[8]; unpack8(raw[r][hf], t8);
#pragma unroll
                for (int j = 0; j < 8; ++j) v[r][hf * 8 + j] = t8[j]; }
    }
    f32x4 g0[2], g1[2];
#pragma unroll
    for (int hf = 0; hf < 2; ++hf) { g0[hf] = *(const f32x4*)(gamma + hf * 512 + lane * 8); g1[hf] = *(const f32x4*)(gamma + hf * 512 + lane * 8 + 4); }
#pragma unroll
    for (int r = 0; r < RB; ++r) {
        float ss = 0.f;
#pragma unroll
        for (int j = 0; j < 16; ++j) ss += v[r][j] * v[r][j];
        ss = wave_sum(ss);
        const float rs = rsqrtf(ss * (1.f / 1024.f) + EPS_);
        const int row = row0 + r;
#pragma unroll
        for (int hf = 0; hf < 2; ++hf) { const int c = hf * 512 + lane * 8;
            float y[8], x8[8];
#pragma unroll
            for (int j = 0; j < 4; ++j) { y[j] = v[r][hf * 8 + j] * rs * g0[hf][j]; y[4 + j] = v[r][hf * 8 + 4 + j] * rs * g1[hf][j]; }
#pragma unroll
            for (int j = 0; j < 8; ++j) x8[j] = v[r][hf * 8 + j];
            if (cpy) *(u32x4*)(cpy + (size_t)row * 1024 + c) = pack8(x8);
            if (outn) { *(f32x4*)(outn + (size_t)row * 1024 + c) = (f32x4){y[0], y[1], y[2], y[3]}; *(f32x4*)(outn + (size_t)row * 1024 + c + 4) = (f32x4){y[4], y[5], y[6], y[7]}; }
            if (H) *(u32x4*)(H + (size_t)row * 1024 + c) = pack8(y); }
    }
}
DEV void phase_rmsnorm(const float* srcf, const bf16_t* srcb, const float* gamma, bf16_t* H, bf16_t* cpy, float* outn) {
    int tid = threadIdx.x; OPQV(tid); const int lane = tid & 63, wave = tid >> 6;
    for (int rq = blockIdx.x * 8 + wave; rq < T_ / 4; rq += gridDim.x * 8) rmsnorm_rows<4>(srcf, srcb, gamma, H, cpy, outn, rq * 4, lane);
}
DEV void phase_rowpass(const bf16_t* P, const float* conv_a, const float* lng, const float* lnb, bf16_t* OA, bf16_t* VN, const float* GLA, const float* GFA) {
    int tid = threadIdx.x; OPQV(tid); const int lane = tid & 63, wave = tid >> 6;
    for (int idx = blockIdx.x * 512 + tid; idx < 64 * 2 * 256; idx += gridDim.x * 512) {
        const int pm = idx >> 9, r = idx & 511, t = r >> 8, c = (r & 255) * 4;
        const bool first = (pm & 7) == 0;
        const float* gf = GFA + ((size_t)(pm * 2 + t) * 2) * 1024 + c;
        const float* gl = GLA + (size_t)(first ? 0 : pm - 1) * 2 * 1024 + c;
        const f32x4 gb = *(const f32x4*)gf, x0 = *(const f32x4*)(gf + 1024);
        f32x4 xm1 = t == 0 ? *(const f32x4*)(gl + 1024) : *(const f32x4*)(GFA + ((size_t)(pm * 2) * 2) * 1024 + 1024 + c);
        f32x4 xm2 = t == 0 ? *(const f32x4*)gl : *(const f32x4*)(gl + 1024);
        if (first) { xm2 = (f32x4){0.f, 0.f, 0.f, 0.f}; if (t == 0) xm1 = xm2; }
        const f32x4 w0 = *(const f32x4*)(conv_a + c), w1 = *(const f32x4*)(conv_a + 1024 + c), w2 = *(const f32x4*)(conv_a + 2048 + c);
        const f32x4 y = gb * (w0 * xm2 + w1 * xm1 + w2 * x0);
        u32x2 o; o.x = cvt_pk_bf16(y[0], y[1]); o.y = cvt_pk_bf16(y[2], y[3]);
        *(u32x2*)(OA + ((size_t)pm * 256 + t) * 1024 + c) = o;
    }
    f32x4 g0[2], g1[2], b0[2], b1[2];
#pragma unroll
    for (int hlf = 0; hlf < 2; ++hlf) { const int c = hlf * 512 + lane * 8; g0[hlf] = *(const f32x4*)(lng + c); g1[hlf] = *(const f32x4*)(lng + c + 4); b0[hlf] = *(const f32x4*)(lnb + c); b1[hlf] = *(const f32x4*)(lnb + c + 4); }
    for (int rp = blockIdx.x * 8 + wave; rp < T_ / 2; rp += gridDim.x * 8) {
        const int row = rp * 2;
        const bf16_t* pr = P + (size_t)row * NP;
        u32x4 vr[2][2];
#pragma unroll
        for (int r = 0; r < 2; ++r)
#pragma unroll
            for (int hlf = 0; hlf < 2; ++hlf) vr[r][hlf] = *(const u32x4*)(pr + (size_t)r * NP + COL_V + hlf * 512 + lane * 8);
#pragma unroll
        for (int r = 0; r < 2; ++r) {
            float v[2][8]; float sm = 0.f;
#pragma unroll
            for (int hlf = 0; hlf < 2; ++hlf) { unpack8(vr[r][hlf], v[hlf]);
#pragma unroll
                for (int j = 0; j < 8; ++j) sm += v[hlf][j]; }
            const float mu = wave_sum(sm) * (1.f / 1024.f);
            float q = 0.f;
#pragma unroll
            for (int hlf = 0; hlf < 2; ++hlf)
#pragma unroll
                for (int j = 0; j < 8; ++j) { const float d = v[hlf][j] - mu; q += d * d; }
            const float rstd = rsqrtf(wave_sum(q) * (1.f / 1024.f) + EPS_);
#pragma unroll
            for (int hlf = 0; hlf < 2; ++hlf) { const int c = hlf * 512 + lane * 8; float o[8];
#pragma unroll
                for (int j = 0; j < 4; ++j) { o[j] = (v[hlf][j] - mu) * rstd * g0[hlf][j] + b0[hlf][j]; o[4 + j] = (v[hlf][4 + j] - mu) * rstd * g1[hlf][j] + b1[hlf][j]; }
                *(u32x4*)(VN + (size_t)(row + r) * 1024 + c) = pack8(o); }
        }
    }
}
DEV void phase_compress(LAS unsigned char* lds, const bf16_t* KV, const float* pos  , const bf16_t* W1T, const bf16_t* W2T, bf16_t* KC, bf16_t* VC) {
    int tid = threadIdx.x; OPQV(tid); const int lane = tid & 63, wv = tid >> 6, fr = lane & 15, g4 = lane >> 4;
    constexpr int PP = 132, HIDO = 4 * 32 * PP * 4;
    LAS float* PART = (LAS float*)lds;
    LAS bf16_t* HID = (LAS bf16_t*)(lds + HIDO);
    for (int item = blockIdx.x; item < 256; item += gridDim.x) {
        const int w = item >> 7, b = (item >> 4) & 7, g = (item >> 2) & 3, qr = item & 3;
        const int kq = wv >> 1, nh = wv & 1;
        const float* posw = pos + w * 2048;
        const bf16_t* w1 = W1T + (size_t)w * 128 * 2048 + (size_t)(nh * 64 + fr) * 2048 + g4 * 8;
        f32x4 acc[2][4];
#pragma unroll
        for (int mt = 0; mt < 2; ++mt)
#pragma unroll
            for (int nt = 0; nt < 4; ++nt) acc[mt][nt] = (f32x4){0.f, 0.f, 0.f, 0.f};
        const int n0 = qr * 32 + fr, n1 = n0 + 16;
        const bool ok0 = n0 < 127, ok1 = n1 < 127;
        const bf16_t* x0 = KV + (size_t)w * KV_TENSOR + ((size_t)(b * 4 + g) * S_ + 16 * min(n0, 126)) * 64 + g4 * 8;
        const bf16_t* x1 = KV + (size_t)w * KV_TENSOR + ((size_t)(b * 4 + g) * S_ + 16 * min(n1, 126)) * 64 + g4 * 8;
#pragma unroll 4
        for (int ks = 0; ks < 16; ++ks) { const int kk = kq * 16 + ks, i = kk >> 1, db = (kk & 1) * 32;
            const f32x4 p0 = *(const f32x4*)(posw + i * 64 + db + g4 * 8), p1 = *(const f32x4*)(posw + i * 64 + db + g4 * 8 + 4);
            const u32x4 xa = *(const u32x4*)(x0 + i * 64 + db);
            const u32x4 xb = *(const u32x4*)(x1 + i * 64 + db);
            bf16x8 bfr[4];
#pragma unroll
            for (int nt = 0; nt < 4; ++nt) bfr[nt] = *(const bf16x8*)(w1 + (size_t)nt * 16 * 2048 + kk * 32);
            float a[8];
            unpack8(xa, a);
#pragma unroll
            for (int j = 0; j < 4; ++j) { a[j] += p0[j]; a[4 + j] += p1[j]; }
#pragma unroll
            for (int j = 0; j < 8; ++j) a[j] = ok0 ? a[j] : 0.f;
            const bf16x8 af0 = as_bf16x8(pack8(a));
            unpack8(xb, a);
#pragma unroll
            for (int j = 0; j < 4; ++j) { a[j] += p0[j]; a[4 + j] += p1[j]; }
#pragma unroll
            for (int j = 0; j < 8; ++j) a[j] = ok1 ? a[j] : 0.f;
            const bf16x8 af1 = as_bf16x8(pack8(a));
#pragma unroll
            for (int nt = 0; nt < 4; ++nt) { acc[0][nt] = __builtin_amdgcn_mfma_f32_16x16x32_bf16(af0, bfr[nt], acc[0][nt], 0, 0, 0);
                acc[1][nt] = __builtin_amdgcn_mfma_f32_16x16x32_bf16(af1, bfr[nt], acc[1][nt], 0, 0, 0); }
        }
#pragma unroll
        for (int mt = 0; mt < 2; ++mt)
#pragma unroll
            for (int nt = 0; nt < 4; ++nt)
#pragma unroll
                for (int r = 0; r < 4; ++r) PART[(kq * 32 + mt * 16 + g4 * 4 + r) * PP + nh * 64 + nt * 16 + fr] = acc[mt][nt][r];
        __syncthreads();
        { const int row = tid >> 4, c8 = (tid & 15) * 8; float hv[8];
#pragma unroll
            for (int j = 0; j < 8; ++j) hv[j] = 0.f;
#pragma unroll
            for (int q = 0; q < 4; ++q) { const f32x4 u0 = *(const LAS f32x4*)(lds + ((q * 32 + row) * PP + c8) * 4), u1 = *(const LAS f32x4*)(lds + ((q * 32 + row) * PP + c8 + 4) * 4);
#pragma unroll
                for (int j = 0; j < 4; ++j) { hv[j] += u0[j]; hv[4 + j] += u1[j]; } }
#pragma unroll
            for (int j = 0; j < 8; ++j) hv[j] = gelu_t(hv[j]);
            *(LAS u32x4*)(lds + HIDO + (row * 136 + c8) * 2) = pack8(hv); }
        __syncthreads();
        { const int mt = wv >> 2, dt = wv & 3;
            const bf16_t* w2 = W2T + (size_t)w * 64 * 128 + (size_t)(dt * 16 + fr) * 128;
            f32x4 o = (f32x4){0.f, 0.f, 0.f, 0.f};
#pragma unroll
            for (int ks = 0; ks < 4; ++ks) { const bf16x8 af = *(const LAS bf16x8*)(lds + HIDO + ((mt * 16 + fr) * 136 + ks * 32 + g4 * 8) * 2);
                const bf16x8 bfr = *(const bf16x8*)(w2 + ks * 32 + g4 * 8);
                o = __builtin_amdgcn_mfma_f32_16x16x32_bf16(af, bfr, o, 0, 0, 0); }
            bf16_t* dst = (w ? VC : KC) + (size_t)(b * 4 + g) * 128 * 64;
#pragma unroll
            for (int r = 0; r < 4; ++r) { const int n = qr * 32 + mt * 16 + g4 * 4 + r; const float ov = n < 127 ? o[r] : 0.f;
                dst[n * 64 + dt * 16 + fr] = (bf16_t)(cvt_pk_bf16(ov, 0.f) & 0xffffu); } }
        __syncthreads();
    }
}
DEV void sgu_item(LAS unsigned char* lds, const bf16_t* P, const bf16_t* VN, const float* sgu_w, const float* sgu_b, bf16_t* OC, int item) {
    int tid = threadIdx.x; OPQV(tid); const int lane = tid & 63, wv = tid >> 6, fr = lane & 15, g4 = lane >> 4;
    LAS bf16_t* VT = (LAS bf16_t*)lds;
    const int g = item & 7, ch = (item >> 3) & 15, b = item >> 7;
    const size_t tok0 = (size_t)b * S_ + ch * 128;
    const int t = wv * 16 + fr;
    const size_t tok = tok0 + t;
    u32x4 vin[4];
#pragma unroll
    for (int it = 0; it < 4; ++it) { const int idx = it * 512 + tid, s = idx >> 4, c8 = (idx & 15) * 8; vin[it] = *(const u32x4*)(VN + (tok0 + s) * 1024 + g * 128 + c8); }
    const float* wrow = sgu_w + ((size_t)g * 128 + t) * 128;
    f32x4 wa[4], wb[4];
#pragma unroll
    for (int ks = 0; ks < 4; ++ks) { wa[ks] = *(const f32x4*)(wrow + ks * 32 + g4 * 8); wb[ks] = *(const f32x4*)(wrow + ks * 32 + g4 * 8 + 4); }
    u32x2 uu[8];
#pragma unroll
    for (int n = 0; n < 8; ++n) uu[n] = *(const u32x2*)(P + tok * NP + COL_U + g * 128 + n * 16 + g4 * 4);
    const float bias = sgu_b[g * 128 + t];
#pragma unroll
    for (int it = 0; it < 4; ++it) { const int idx = it * 512 + tid, s = idx >> 4, c8 = (idx & 15) * 8;
#pragma unroll
        for (int j = 0; j < 4; ++j) { VT[(c8 + 2 * j) * 136 + s] = (bf16_t)(vin[it][j] & 0xffffu); VT[(c8 + 2 * j + 1) * 136 + s] = (bf16_t)(vin[it][j] >> 16); } }
    __syncthreads();
    f32x4 acc[8];
#pragma unroll
    for (int n = 0; n < 8; ++n) acc[n] = (f32x4){0.f, 0.f, 0.f, 0.f};
#pragma unroll
    for (int ks = 0; ks < 4; ++ks) { const int s0 = ks * 32 + g4 * 8;
        float wf[8] = {wa[ks][0], wa[ks][1], wa[ks][2], wa[ks][3], wb[ks][0], wb[ks][1], wb[ks][2], wb[ks][3]};
#pragma unroll
        for (int j = 0; j < 8; ++j) if (s0 + j > t) wf[j] = 0.f;
        const bf16x8 wfr = as_bf16x8(pack8(wf));
#pragma unroll
        for (int n = 0; n < 8; ++n) { const bf16x8 vf = *(const LAS bf16x8*)(lds + ((n * 16 + fr) * 136 + s0) * 2);
            acc[n] = __builtin_amdgcn_mfma_f32_16x16x32_bf16(vf, wfr, acc[n], 0, 0, 0); } }
#pragma unroll
    for (int n = 0; n < 8; ++n) { const int c = g * 128 + n * 16 + g4 * 4;
        u32x2 w; w.x = cvt_pk_bf16(bflo(uu[n].x) * (acc[n][0] + bias), bfhi(uu[n].x) * (acc[n][1] + bias)); w.y = cvt_pk_bf16(bflo(uu[n].y) * (acc[n][2] + bias), bfhi(uu[n].y) * (acc[n][3] + bias));
        *(u32x2*)(OC + tok * 1024 + c) = w; }
    __syncthreads();
}
DEV void phase_actfix(const float* GL, const float* GF, const float* cw, bf16_t* ACT, int pm0, int npm) {
    int tid = threadIdx.x; OPQV(tid);
    for (int idx = tid; idx < npm * 768; idx += 512) {
        const int pm = pm0 + idx / 768, r = idx % 768, t = r / 384, c = (r - t * 384) * 8;
        const bool first = (pm & 7) == 0;
        const float* gf = GF + ((size_t)(pm * 2 + t) * 2) * DFF + c;
        const float* gl = GL + (size_t)(first ? 0 : pm - 1) * 2 * DFF + c;
        const float* gm1p = t == 0 ? gl + DFF : GF + ((size_t)(pm * 2) * 2) * DFF + c;
        const float* gm2p = t == 0 ? gl : gl + DFF;
        float y[8];
#pragma unroll
        for (int hf = 0; hf < 2; ++hf) { const f32x4 g0 = *(const f32x4*)(gf + hf * 4), vv = *(const f32x4*)(gf + DFF + hf * 4);
            f32x4 gm1 = *(const f32x4*)(gm1p + hf * 4), gm2 = *(const f32x4*)(gm2p + hf * 4);
            if (first) { gm2 = (f32x4){0.f, 0.f, 0.f, 0.f}; if (t == 0) gm1 = gm2; }
            const f32x4 w0 = *(const f32x4*)(cw + c + hf * 4), w1 = *(const f32x4*)(cw + DFF + c + hf * 4), w2 = *(const f32x4*)(cw + 2 * DFF + c + hf * 4);
#pragma unroll
            for (int j = 0; j < 4; ++j) y[hf * 4 + j] = gelu_t(w0[j] * gm2[j] + w1[j] * gm1[j] + w2[j] * g0[j]) * vv[j]; }
        *(u32x4*)(ACT + ((size_t)pm * 256 + t) * DFF + c) = pack8(y);
    }
}

constexpr int AT_KS = 0, AT_VT = 18432, AT_BT = 36864, AT_BK = 38944, AT_IMP = 39936, AT_MASK = 72704, AT_IMPF = 72960, AT_RB = 81152, AT_NEXT = 83200;

struct KVRegs { u32x4 k, v; };
DEV KVRegs kv_fetch(const bf16_t* kbase, const bf16_t* vbase, int tid) {
    KVRegs r;
    r.k = *(const u32x4*)(kbase + tid * 8); r.v = *(const u32x4*)(vbase + (tid & 63) * 64 + (tid >> 6) * 8); return r;
}
DEV void kv_store(LAS unsigned char* lds, const KVRegs& r, int buf, int tid) {
    const int key = tid >> 3, c8 = (tid & 7) * 8;
    unsigned kw = AT_KS + buf * 9216 + (key * 72 + c8) * 2, vw = AT_VT + buf * 9216 + ((tid >> 6) * 8 * 72 + (tid & 63)) * 2; OPQV(kw); OPQV(vw);
    *(LAS u32x4*)(lds + kw) = r.k;
#pragma unroll
    for (int j = 0; j < 4; ++j) { *(LAS bf16_t*)(lds + vw + j * 288) = (bf16_t)(r.v[j] & 0xffffu); *(LAS bf16_t*)(lds + vw + j * 288 + 144) = (bf16_t)(r.v[j] >> 16); }
}

DEV void attn_tile(LAS unsigned char* lds, const bf16x8 (&qf)[2][2], int tl, int kpos0, int mode, bool near, bool rowsel, const float (&cbias)[2],
                   unsigned kb, unsigned vb_, unsigned btb, int g4, float (&mrun)[2], float (&lrun)[2], f32x4 (&O)[2][4]) {
    f32x4 sc[2][4];
    float ci[2];
#pragma unroll
    for (int hh = 0; hh < 2; ++hh) { const float mne = mrun[hh] < -1e29f ? 0.f : mrun[hh];
        ci[hh] = near ? -mne : (((mode == 1 && !rowsel) ? NEG_ : cbias[hh]) - mne); }
    {
        bf16x8 kf[4][2];
#pragma unroll
        for (int kt = 0; kt < 4; ++kt) { kf[kt][0] = *(const LAS bf16x8*)(lds + kb + kt * 2304); kf[kt][1] = *(const LAS bf16x8*)(lds + kb + kt * 2304 + 64); }
        __builtin_amdgcn_sched_barrier(0);
#pragma unroll
        for (int kt = 0; kt < 4; ++kt)
#pragma unroll
            for (int hh = 0; hh < 2; ++hh) sc[hh][kt] = __builtin_amdgcn_mfma_f32_16x16x32_bf16(kf[kt][0], qf[hh][0], (f32x4){ci[hh], ci[hh], ci[hh], ci[hh]}, 0, 0, 0);
#pragma unroll
        for (int kt = 0; kt < 4; ++kt)
#pragma unroll
            for (int hh = 0; hh < 2; ++hh) sc[hh][kt] = __builtin_amdgcn_mfma_f32_16x16x32_bf16(kf[kt][1], qf[hh][1], sc[hh][kt], 0, 0, 0);
    }
    if (near) {
#pragma unroll
        for (int kt = 0; kt < 4; ++kt)
#pragma unroll
            for (int r = 0; r < 4; ++r) { const int dist = tl - (kpos0 + kt * 16 + g4 * 4 + r);
                const bool valid = dist >= 0 && (mode == 1 ? rowsel : dist < 512);
                const int idx = dist < 0 ? 0 : (dist > 128 ? 128 : dist);
#pragma unroll
                for (int hh = 0; hh < 2; ++hh) { const float s = sc[hh][kt][r] + *(const LAS float*)(lds + btb + idx * 4 + hh * 516); sc[hh][kt][r] = valid ? s : NEG_; } }
    }
    bf16x8 pf[2][2];
#pragma unroll
    for (int hh = 0; hh < 2; ++hh) {
        float lm = fmaxf(fmaxf(sc[hh][0][0], sc[hh][0][1]), fmaxf(sc[hh][0][2], sc[hh][0][3]));
#pragma unroll
        for (int kt = 1; kt < 4; ++kt) lm = fmaxf(lm, fmaxf(fmaxf(sc[hh][kt][0], sc[hh][kt][1]), fmaxf(sc[hh][kt][2], sc[hh][kt][3])));
        const bool inval = mrun[hh] < -1e29f;
        if (__any(lm > (inval ? -1e29f : 20.f))) {
            float mx = fmaxf(lm, __shfl_xor(lm, 16)); mx = fmaxf(mx, __shfl_xor(mx, 32));
            float d = 0.f, alpha = 1.f;
            if (mx > -1e29f) { d = inval ? mx : fmaxf(mx, 0.f); alpha = inval ? 1.f : __builtin_amdgcn_exp2f(-d); mrun[hh] = inval ? mx : mrun[hh] + d; }
#pragma unroll
            for (int kt = 0; kt < 4; ++kt) sc[hh][kt] = sc[hh][kt] - d;
            lrun[hh] *= alpha;
#pragma unroll
            for (int dt = 0; dt < 4; ++dt) O[hh][dt] = O[hh][dt] * alpha;
        }
        float rs = 0.f;
#pragma unroll
        for (int kt = 0; kt < 4; ++kt)
#pragma unroll
            for (int r = 0; r < 4; ++r) { const float p = __builtin_amdgcn_exp2f(sc[hh][kt][r]); sc[hh][kt][r] = p; rs += p; }
        lrun[hh] += rs;
#pragma unroll
        for (int kc = 0; kc < 2; ++kc) { u32x4 w; w.x = cvt_pk_bf16(sc[hh][2 * kc][0], sc[hh][2 * kc][1]); w.y = cvt_pk_bf16(sc[hh][2 * kc][2], sc[hh][2 * kc][3]);
            w.z = cvt_pk_bf16(sc[hh][2 * kc + 1][0], sc[hh][2 * kc + 1][1]); w.w = cvt_pk_bf16(sc[hh][2 * kc + 1][2], sc[hh][2 * kc + 1][3]); pf[hh][kc] = as_bf16x8(w); }
    }
#pragma unroll
    for (int dt = 0; dt < 4; ++dt)
#pragma unroll
        for (int kc = 0; kc < 2; ++kc) {
            const u32x2 va = *(const LAS u32x2*)(lds + vb_ + dt * 2304 + kc * 64);
            const u32x2 vb = *(const LAS u32x2*)(lds + vb_ + dt * 2304 + kc * 64 + 32);
            const bf16x8 vf = as_bf16x8((u32x4){va.x, va.y, vb.x, vb.y});
#pragma unroll
            for (int hh = 0; hh < 2; ++hh) O[hh][dt] = __builtin_amdgcn_mfma_f32_16x16x32_bf16(vf, pf[hh][kc], O[hh][dt], 0, 0, 0);
        }
}

DEV void attn_item(LAS unsigned char* lds, const bf16_t* P, const bf16_t* QB, const bf16_t* KV, const bf16_t* KC, const bf16_t* VC, const float* rel_bias, bf16_t* OB, int b, int g, int qt) {
    int tid = threadIdx.x; OPQV(tid);
    const int lane = tid & 63, wave = tid >> 6, fr = lane & 15, g4 = lane >> 4;
    const int qs = wave >> 1, hp = wave & 1;
    const int tl = qt * 64 + qs * 16 + fr;
    const size_t tok = (size_t)b * S_ + tl;
    unsigned kb = AT_KS + (fr * 72 + g4 * 8) * 2, vb1 = AT_VT + (fr * 72 + g4 * 4) * 2, vb2 = AT_VT + (fr * 136 + g4 * 4) * 2, btb = AT_BT + hp * 1032;
    OPQV(kb); OPQV(vb1); OPQV(vb2); OPQV(btb);
    LAS float* BT = (LAS float*)(lds + AT_BT);
    const LAS int* BK = (const LAS int*)(lds + AT_BK);
    LAS float* IA = (LAS float*)(lds + AT_IMP);
    LAS float* IB = (LAS float*)(lds + AT_IMP + 16384);
    LAS unsigned* MASK = (LAS unsigned*)(lds + AT_MASK);

    bf16x8 qf[2][2];
#pragma unroll
    for (int hh = 0; hh < 2; ++hh)
#pragma unroll
        for (int ks = 0; ks < 2; ++ks) { float qv[8]; unpack8(*(const u32x4*)(QB + tok * 1024 + (g * 4 + hp * 2 + hh) * 64 + ks * 32 + g4 * 8), qv);
#pragma unroll
            for (int e = 0; e < 8; ++e) qv[e] *= QSC_;
            qf[hh][ks] = as_bf16x8(pack8(qv)); }
    float gate[3][2];
#pragma unroll
    for (int br = 0; br < 3; ++br)
#pragma unroll
        for (int hh = 0; hh < 2; ++hh) gate[br][hh] = bf2f(P[tok * NP + COL_GN + br * 16 + g * 4 + hp * 2 + hh]);
    f32x4 F[2][4];
#pragma unroll
    for (int hh = 0; hh < 2; ++hh)
#pragma unroll
        for (int dt = 0; dt < 4; ++dt) F[hh][dt] = (f32x4){0.f, 0.f, 0.f, 0.f};

    const bf16_t* pbg = KV + (size_t)(b * 4 + g) * S_ * 64;
    KVRegs pre = kv_fetch(pbg + 2 * KV_TENSOR, pbg + 3 * KV_TENSOR, tid);
    {
        const bf16_t* kc = KC + (size_t)(b * 4 + g) * 128 * 64; const bf16_t* vc = VC + (size_t)(b * 4 + g) * 128 * 64;
#pragma unroll
        for (int it = 0; it < 2; ++it) { const int idx = it * 512 + tid, key = idx >> 3, c8 = (idx & 7) * 8;
            const u32x4 kv = *(const u32x4*)(kc + key * 64 + c8); const u32x4 vv = *(const u32x4*)(vc + key * 64 + c8);
            unsigned kw = AT_KS + (key * 72 + c8) * 2, vw = AT_VT + (c8 * 136 + key) * 2; OPQV(kw); OPQV(vw);
            *(LAS u32x4*)(lds + kw) = kv;
#pragma unroll
            for (int j = 0; j < 4; ++j) { *(LAS bf16_t*)(lds + vw + j * 544) = (bf16_t)(vv[j] & 0xffffu); *(LAS bf16_t*)(lds + vw + j * 544 + 272) = (bf16_t)(vv[j] >> 16); } }
        for (int e = tid; e < 4 * 129; e += 512) { const int r = e / 129, idx = e - r * 129; BT[e] = LOG2E_ * *(const LAS float*)(lds + AT_RB + (BK[idx] * 16 + g * 4 + r) * 4); }
    }
    __syncthreads();
    {
        const int nkt = min(8, (4 * qt + 2) / 16 + 1);
        float ia[8], ib[8];
#pragma unroll
        for (int kt = 0; kt < 8; ++kt) { ia[kt] = 0.f; ib[kt] = 0.f; }
#pragma unroll
        for (int hh = 0; hh < 2; ++hh) {
            f32x4 sc[8];
#pragma unroll
            for (int kt = 0; kt < 8; ++kt) {
                if (kt < nkt) {
                    const bf16x8 k0 = *(const LAS bf16x8*)(lds + kb + kt * 2304);
                    const bf16x8 k1 = *(const LAS bf16x8*)(lds + kb + kt * 2304 + 64);
                    f32x4 a = (f32x4){0.f, 0.f, 0.f, 0.f};
                    a = __builtin_amdgcn_mfma_f32_16x16x32_bf16(k0, qf[hh][0], a, 0, 0, 0);
                    a = __builtin_amdgcn_mfma_f32_16x16x32_bf16(k1, qf[hh][1], a, 0, 0, 0);
#pragma unroll
                    for (int r = 0; r < 4; ++r) { const int n = kt * 16 + g4 * 4 + r; const int dist = tl - (16 * n + 31);
                        const int idx = dist < 0 ? 0 : (dist > 128 ? 128 : dist);
                        const float s = a[r] + *(const LAS float*)(lds + btb + idx * 4 + hh * 516);
                        a[r] = dist >= 0 ? s : NEG_; }
                    sc[kt] = a;
                } else sc[kt] = (f32x4){NEG_, NEG_, NEG_, NEG_};
            }
            float mx = NEG_;
#pragma unroll
            for (int kt = 0; kt < 8; ++kt)
#pragma unroll
                for (int r = 0; r < 4; ++r) mx = fmaxf(mx, sc[kt][r]);
            mx = fmaxf(mx, __shfl_xor(mx, 16)); mx = fmaxf(mx, __shfl_xor(mx, 32));
            float rs = 0.f;
#pragma unroll
            for (int kt = 0; kt < 8; ++kt)
#pragma unroll
                for (int r = 0; r < 4; ++r) { const float s = sc[kt][r]; const float p = s > -1e29f ? __builtin_amdgcn_exp2f(s - mx) : 0.f; sc[kt][r] = p; rs += p; }
            rs += __shfl_xor(rs, 16); rs += __shfl_xor(rs, 32);
            const float inv = rs > 0.f ? 1.f / rs : 0.f;
#pragma unroll
            for (int kt = 0; kt < 8; ++kt) { sc[kt] = sc[kt] * inv; ia[kt] += (sc[kt][0] + sc[kt][1]) + (sc[kt][2] + sc[kt][3]); ib[kt] += sc[kt][3]; }
            f32x4 Oc[4];
#pragma unroll
            for (int dt = 0; dt < 4; ++dt) Oc[dt] = (f32x4){0.f, 0.f, 0.f, 0.f};
#pragma unroll
            for (int kc = 0; kc < 4; ++kc) {
                if (2 * kc < nkt) {
                    u32x4 w; w.x = cvt_pk_bf16(sc[2 * kc][0], sc[2 * kc][1]); w.y = cvt_pk_bf16(sc[2 * kc][2], sc[2 * kc][3]);
                    w.z = cvt_pk_bf16(sc[2 * kc + 1][0], sc[2 * kc + 1][1]); w.w = cvt_pk_bf16(sc[2 * kc + 1][2], sc[2 * kc + 1][3]);
                    const bf16x8 pf = as_bf16x8(w);
#pragma unroll
                    for (int dt = 0; dt < 4; ++dt) {
                        const u32x2 va = *(const LAS u32x2*)(lds + vb2 + dt * 4352 + kc * 64);
                        const u32x2 vb = *(const LAS u32x2*)(lds + vb2 + dt * 4352 + kc * 64 + 32);
                        const bf16x8 vf = as_bf16x8((u32x4){va.x, va.y, vb.x, vb.y});
                        Oc[dt] = __builtin_amdgcn_mfma_f32_16x16x32_bf16(vf, pf, Oc[dt], 0, 0, 0);
                    }
                }
            }
#pragma unroll
            for (int dt = 0; dt < 4; ++dt) F[hh][dt] = F[hh][dt] + Oc[dt] * gate[0][hh];
            __builtin_amdgcn_sched_barrier(0);
        }
        unsigned iw = AT_IMP + ((hp * 64 + qs * 16 + fr) * 32 + g4) * 4; OPQV(iw);
#pragma unroll
        for (int kt = 0; kt < 8; ++kt) { *(LAS float*)(lds + iw + kt * 16) = ia[kt]; *(LAS float*)(lds + iw + kt * 16 + 16384) = ib[kt]; }
    }
    __syncthreads();
    {
        LAS float* IMPF = (LAS float*)(lds + AT_IMPF);
#pragma unroll
        for (int it = 0; it < 4; ++it) { const int e = it * 512 + tid, q = e >> 5, j = e & 31;
            float v = IA[q * 32 + j] + IA[(64 + q) * 32 + j]; if (j > 0) v += IB[q * 32 + j - 1] + IB[(64 + q) * 32 + j - 1];
            IMPF[e] = v; }
        __syncthreads();
        const int cur = qt;
        const unsigned forced = 1u | (1u << cur) | (cur > 0 ? (1u << (cur - 1)) : 0u);
        const int need = 8 - __popc(forced);
        for (int it = 0; it < 4; ++it) { const int q = wave * 8 + it * 2 + (lane >> 5), j = lane & 31;
            const float v = IMPF[q * 32 + j]; int rank = 0;
            for (int jp = 1; jp <= cur - 2; ++jp) { const float vp = IMPF[q * 32 + jp]; rank += (vp > v || (vp == v && jp < j)) ? 1 : 0; }
            const bool sel = (j >= 1) && (j <= cur - 2) && (rank < need);
            const unsigned long long bal = __ballot(sel);
            const unsigned mq = forced | (unsigned)(lane < 32 ? bal : (bal >> 32));
            if (j == 0) MASK[q] = mq; }
    }
    __syncthreads();
    const unsigned mymask = MASK[qs * 16 + fr];
    unsigned anym = MASK[lane];
#pragma unroll
    for (int o = 32; o >= 1; o >>= 1) anym |= __shfl_xor(anym, o);
    anym = __builtin_amdgcn_readfirstlane(anym);
    {
        float cbias[2]; cbias[0] = *(const LAS float*)(lds + btb + 512); cbias[1] = *(const LAS float*)(lds + btb + 512 + 516);
        float mrun[2] = {NEG_, NEG_}, lrun[2] = {0.f, 0.f}; f32x4 O[2][4];
#pragma unroll
        for (int hh = 0; hh < 2; ++hh)
#pragma unroll
            for (int dt = 0; dt < 4; ++dt) O[hh][dt] = (f32x4){0.f, 0.f, 0.f, 0.f};
        unsigned rem = anym & (qt >= 31 ? 0xffffffffu : ((2u << qt) - 1u)); rem &= ~1u;
        int mode = 1, j = 0, buf = 0;
        for (;;) {
            kv_store(lds, pre, buf, tid);
            __syncthreads();
            int mode_n = mode, j_n = 0; bool more = true;
            if (mode == 1) { if (rem != 0u) { j_n = __builtin_ctz(rem); rem &= rem - 1u; } else { mode_n = 2; j_n = max(0, qt - 8); } }
            else { j_n = j + 1; more = j_n <= qt; }
            if (more) { const bf16_t* base = pbg + (size_t)j_n * 64 * 64 + (mode_n == 1 ? 2 : 4) * KV_TENSOR; pre = kv_fetch(base, base + KV_TENSOR, tid); }
            const bool near = (j >= qt - 2) || (mode == 2 && j == qt - 8);
            attn_tile(lds, qf, tl, j * 64, mode, near, ((mymask >> j) & 1u) != 0u, cbias, kb + buf * 9216, vb1 + buf * 9216, btb, g4, mrun, lrun, O);
            if (mode_n != mode || !more) {
#pragma unroll
                for (int hh = 0; hh < 2; ++hh) { float lt = lrun[hh]; lt += __shfl_xor(lt, 16); lt += __shfl_xor(lt, 32); const float sc = lt > 0.f ? gate[mode][hh] / lt : 0.f;
#pragma unroll
                    for (int dt = 0; dt < 4; ++dt) { F[hh][dt] = F[hh][dt] + O[hh][dt] * sc; O[hh][dt] = (f32x4){0.f, 0.f, 0.f, 0.f}; }
                    mrun[hh] = NEG_; lrun[hh] = 0.f; }
            }
            if (!more) break;
            mode = mode_n; j = j_n; buf ^= 1;
        }
    }
#pragma unroll
    for (int hh = 0; hh < 2; ++hh)
#pragma unroll
        for (int dt = 0; dt < 4; ++dt) { u32x2 w; w.x = cvt_pk_bf16(F[hh][dt][0], F[hh][dt][1]); w.y = cvt_pk_bf16(F[hh][dt][2], F[hh][dt][3]);
            *(u32x2*)(OB + tok * 1024 + (g * 4 + hp * 2 + hh) * 64 + dt * 16 + g4 * 4) = w; }
}

DEV void phase_mix(LAS unsigned char* lds, const bf16_t* P, const bf16_t* QB, const bf16_t* KV, const bf16_t* KC, const bf16_t* VC, const float* rel_bias, bf16_t* OB,
                   const bf16_t* VN, const float* sgu_w, const float* sgu_b, bf16_t* OC, int* ctr) {
    int tid = threadIdx.x; OPQV(tid);
    LAS int* BK = (LAS int*)(lds + AT_BK);
    if (tid < 129) { int bk; if (tid < 16) bk = tid; else { const float lr = log2f((float)tid * (1.f / 16.f)) * (1.f / 3.f); bk = 16 + (int)(lr * 16.f); if (bk > 31) bk = 31; } BK[tid] = bk; }
    *(LAS float*)(lds + AT_RB + tid * 4) = rel_bias[tid];
    __syncthreads();
    for (;;) {
        if (tid == 0) *(LAS int*)(lds + AT_NEXT) = atomicAdd(ctr, 1);
        __syncthreads();
        const int i = *(const LAS int*)(lds + AT_NEXT);
        __syncthreads();
        if (i >= 2048) break;
        if (i < 1024) attn_item(lds, P, QB, KV, KC, VC, rel_bias, OB, (i & 31) >> 2, i & 3, 31 - (i >> 5));
        else sgu_item(lds, P, VN, sgu_w, sgu_b, OC, i - 1024);
        __syncthreads();
    }
}


#define XB_TMO      128
#define XB_XCNT(j)  (256  + 64 * (j))
#define XB_XSUB(j)  (1280 + 64 * (j))
#define XB_XGEN(j)  (2304 + 64 * (j))
#define XB_TOP      3328
#define XB_TOPGEN   3392
#define XCD_BAR_WORDS 3456
#define XB_SPIN_CAP (1u << 20)
DEV unsigned xb_ld(unsigned* p)              { return __hip_atomic_load(p, __ATOMIC_RELAXED, __HIP_MEMORY_SCOPE_AGENT); }
DEV unsigned xb_add(unsigned* p, unsigned v) { return __hip_atomic_fetch_add(p, v, __ATOMIC_RELAXED, __HIP_MEMORY_SCOPE_AGENT); }
DEV unsigned xb_xcc_id() { return (unsigned)__builtin_amdgcn_s_getreg((3 << 11) | 20) & 0xFu; }
#define XB_SPIN(cond, bar) do { unsigned _sp = 0; while (cond) { __builtin_amdgcn_s_sleep(1); \
    if ((++_sp & 255u) == 0u) { if (xb_ld(&(bar)[XB_TMO])) break; if (_sp > XB_SPIN_CAP) { atomicAdd(&(bar)[XB_TMO], 1u); break; } } } } while (0)
struct XcdBarrier { unsigned* bar; unsigned x; volatile LAS unsigned* st; };
DEV XcdBarrier xcd_barrier_post(unsigned* bar, volatile LAS unsigned* st) {
    XcdBarrier b; b.bar = bar; b.x = xb_xcc_id(); b.st = st;
    if (threadIdx.x == 0) (void)xb_add(&bar[XB_XCNT(b.x)], 1u);
    return b;
}
DEV void xcd_barrier_complete(unsigned* bar, unsigned x, unsigned& nloc, unsigned& nx) {
    const unsigned G = gridDim.x * gridDim.y * gridDim.z;
    unsigned sum, cnt, mine, sp = 0u;
    for (;;) {
        sum = 0u; cnt = 0u; mine = 0u;
#pragma unroll
        for (unsigned j = 0; j < 16; ++j) { const unsigned c = xb_ld(&bar[XB_XCNT(j)]); sum += c; cnt += (c > 0u) ? 1u : 0u; mine = (j == x) ? c : mine; }
        if (sum == G) break;
        __builtin_amdgcn_s_sleep(1);
        if ((++sp & 255u) == 0u) { if (xb_ld(&bar[XB_TMO])) break; if (sp > XB_SPIN_CAP) { atomicAdd(&bar[XB_TMO], 1u); break; } }
    }
    nloc = mine > 0u ? mine : 1u; nx = cnt > 0u ? cnt : 1u;
}
DEV void xcd_barrier(const XcdBarrier& b) {
    asm volatile("s_waitcnt vmcnt(0)" ::: "memory");
    __syncthreads();
    if (threadIdx.x == 0) {
        unsigned* bar = b.bar;
        __builtin_amdgcn_s_waitcnt(0);
        unsigned nloc = b.st[0], nx = b.st[1];
        if (nloc == 0u) { xcd_barrier_complete(bar, b.x, nloc, nx); b.st[0] = nloc; b.st[1] = nx; }
        const unsigned old = xb_add(&bar[XB_XSUB(b.x)], 1u);
        const unsigned gen = old / nloc;
        if (old + 1u == (gen + 1u) * nloc) {
            __builtin_amdgcn_fence(__ATOMIC_RELEASE, "agent");
            asm volatile("s_waitcnt vmcnt(0)" ::: "memory");
            const unsigned og = xb_add(&bar[XB_TOP], 1u);
            const unsigned tg = og / nx;
            if (og + 1u == (tg + 1u) * nx) xb_add(&bar[XB_TOPGEN], 1u);
            else XB_SPIN(xb_ld(&bar[XB_TOPGEN]) == tg, bar);
            __builtin_amdgcn_fence(__ATOMIC_ACQUIRE, "agent");
            xb_add(&bar[XB_XGEN(b.x)], 1u);
            asm volatile("s_waitcnt vmcnt(0)" ::: "memory");
        } else {
            XB_SPIN(xb_ld(&bar[XB_XGEN(b.x)]) == gen, bar);
            __builtin_amdgcn_fence(__ATOMIC_ACQUIRE, "agent");
            asm volatile("s_waitcnt vmcnt(0)" ::: "memory");
        }
    }
    __syncthreads();
}

typedef const __attribute__((address_space(4))) Params* KParams;
__global__ void __launch_bounds__(512, 2) fwd_mega(Params p_unused) {
    extern __shared__ __attribute__((aligned(16))) unsigned char lds_raw[];
    LAS unsigned char* lds = (LAS unsigned char*)lds_raw;
    { volatile LAS unsigned* st = (volatile LAS unsigned*)(lds + 131072); if (threadIdx.x < 4) st[threadIdx.x] = 0u; }
    __syncthreads();
    KParams kp0 = (KParams)__builtin_amdgcn_kernarg_segment_ptr();
    XcdBarrier xbar = xcd_barrier_post((unsigned*)(kp0->ws + WS_BAR), (volatile LAS unsigned*)(lds + 131072));
    const int ph_lo = kp0->ph_lo, ph_hi = kp0->ph_hi;

    for (int ph = ph_lo; ph < ph_hi; ++ph) {
        KParams kp = (KParams)__builtin_amdgcn_kernarg_segment_ptr(); OPQS(kp);
        struct { KParams k; DEV const float* operator[](int i) const { return k->in[i]; } } pin{kp};
        unsigned char* ws = kp->ws;
        bf16_t* WIN = (bf16_t*)(ws + WS_WIN); bf16_t* WBR = (bf16_t*)(ws + WS_WBR); bf16_t* WO = (bf16_t*)(ws + WS_WO); bf16_t* WUP = (bf16_t*)(ws + WS_WUP);
        bf16_t* WDN = (bf16_t*)(ws + WS_WDN); bf16_t* W1T = (bf16_t*)(ws + WS_W1T); bf16_t* W2T = (bf16_t*)(ws + WS_W2T);
        bf16_t* KC = (bf16_t*)(ws + WS_KC); bf16_t* VC = (bf16_t*)(ws + WS_VC); bf16_t* H = (bf16_t*)(ws + WS_H); bf16_t* P = (bf16_t*)(ws + WS_P);
        bf16_t* O3 = (bf16_t*)(ws + WS_O3);
        bf16_t* OA = O3; bf16_t* OB = O3 + (size_t)T_ * 1024; bf16_t* OC = O3 + (size_t)2 * T_ * 1024;
        bf16_t* X = (bf16_t*)(ws + WS_X); float* OUT = kp->out;
        const int G = gridDim.x, c = blockIdx.x;
        if (ph == NPHASE - 1) {
            if (PHON(10)) phase_rmsnorm(nullptr, X, pin[20], nullptr, nullptr, OUT);
        } else {
            const int l = ph / 10, k = ph % 10;
            if (k == 0) { if (PHON(0)) {
                if (l == 0 && blockIdx.x == 0 && threadIdx.x < 4) ((int*)(ws + WS_MF))[threadIdx.x * 64] = 0;
                convT<128>(lds, pin[3] + (size_t)l * 1024 * NIN, 1024, NIN, WIN, NP, 1, 0);
                convT<128>(lds, pin[12] + (size_t)l * 1024 * 1024, 1024, 1024, WBR, 1024, 0, 192);
                convT<128>(lds, pin[13] + (size_t)l * 1024 * 1024, 1024, 1024, WBR + (size_t)1024 * 1024, 1024, 0, 192);
                convT<128>(lds, pin[14] + (size_t)l * 1024 * 1024, 1024, 1024, WBR + (size_t)2048 * 1024, 1024, 0, 192);
                convT<128>(lds, pin[15] + (size_t)l * 1024 * 1024, 1024, 1024, WO, 1024, 0, 192);
                convT<128>(lds, pin[17] + (size_t)l * 1024 * 6144, 1024, 6144, WUP, 6144, 2, 192);
                convT<128>(lds, pin[19] + (size_t)l * 3072 * 1024, 3072, 1024, WDN, 1024, 0, 192);
                convT<128>(lds, pin[6] + (size_t)(l * 2 + 0) * 2048 * 128, 2048, 128, W1T, 128, 0, 0);
                convT<128>(lds, pin[6] + (size_t)(l * 2 + 1) * 2048 * 128, 2048, 128, W1T + (size_t)128 * 2048, 128, 0, 64);
                convT<64>(lds, pin[7] + (size_t)(l * 2 + 0) * 128 * 64, 128, 64, W2T, 64, 0, 128);
                convT<64>(lds, pin[7] + (size_t)(l * 2 + 1) * 128 * 64, 128, 64, W2T + (size_t)64 * 128, 64, 0, 130);
                phase_rmsnorm(l == 0 ? pin[0] : nullptr, X, pin[2] + l * 1024, H, l == 0 ? X : nullptr, nullptr); }
            } else if (k == 1) { if (PHON(1)) {
                pg8::Gemm g{H, WIN, T_, NP, 1024}; pg8::StaticOrder S; S.init(T_, NP, G, c); pg8::EpiProj E{P, NP, 0, (bf16_t*)(ws + WS_KV), OA, (bf16_t*)(ws + WS_QB), pin[4] + (size_t)l * 3 * 1024, (float*)(ws + WS_GLA), (float*)(ws + WS_GFA), lds + LDS_EX};
                pg8::gemm_phase(lds, g, S, E); }
            } else if (k == 2) { if (PHON(2)) {
                phase_compress(lds, (const bf16_t*)(ws + WS_KV), pin[5] + (size_t)l * 2 * 2048, W1T, W2T, KC, VC);
                phase_rowpass(P, pin[4] + (size_t)l * 3 * 1024, pin[10] + l * 1024, pin[11] + l * 1024, OA, H  , (const float*)(ws + WS_GLA), (const float*)(ws + WS_GFA)); }
            } else if (k == 3) { if (PHON(3)) {
                if (PHON(11)) phase_mix(lds, P, (const bf16_t*)(ws + WS_QB), (const bf16_t*)(ws + WS_KV), KC, VC, pin[1], OB, H  , pin[8] + (size_t)l * 8 * 128 * 128, pin[9] + (size_t)l * 8 * 128, OC, (int*)(ws + WS_MF) + l * 64); }
            } else if (k == 4) { if (PHON(4)) {
                pg8::Gemm g{O3, WBR, 3 * T_, 3072, 1024}; pg8::BranchOrder S; S.init(G, c); pg8::EpiBranch E{P, H  };
                pg8::gemm_phase(lds, g, S, E); }
            } else if (k == 5) { if (PHON(5)) {
                pg8::Gemm g{H  , WO, T_, 1024, 1024}; pg8::StaticOrder S; S.init(T_, 1024, G, c); pg8::EpiRes E{X};
                pg8::gemm_phase(lds, g, S, E); }
            } else if (k == 6) { if (PHON(6)) {
                phase_rmsnorm(nullptr, X, pin[16] + l * 1024, H, nullptr, nullptr); }
            } else if (k == 7) { if (PHON(7)) {
                pg8::Gemm g{H, WUP, T_, 6144, 1024}; pg8::StaticOrder S; S.init(T_, 6144, G, c);
                pg8::EpiAct E{O3  , pin[18] + (size_t)l * 3 * DFF, (float*)(ws + WS_GL), (float*)(ws + WS_GF), lds + LDS_EX};
                pg8::gemm_phase(lds, g, S, E); }
            } else if (k == 8) {
                continue;
            } else { if (PHON(9)) {
                pg8::Gemm g{O3  , WDN, T_, 1024, 3072}; pg8::StaticOrder S; S.init(T_, 1024, G, c); pg8::EpiRes E{X};
                for (int i = 0;; ++i) { pg8::Unit uu; if (!S.next(i, uu)) break;
                    phase_actfix((const float*)(ws + WS_GL), (const float*)(ws + WS_GF), pin[18] + (size_t)l * 3 * DFF, O3  , uu.pm, 1); }
                asm volatile("s_waitcnt vmcnt(0)" ::: "memory"); __syncthreads();
                pg8::gemm_phase(lds, g, S, E); }
            }
        }
        if (ph + 1 < ph_hi) { if (ph == ph_lo) cg::this_grid().sync(); else xcd_barrier(xbar); }
    }
}

extern "C" void kernel_launch(void* const* d_in, const int* in_sizes, int n_in, void* d_out, int out_size, void* d_ws, size_t ws_size, hipStream_t stream) {
    static int grid = 0;
    if (grid == 0) {
        if (n_in != 21 || out_size != T_ * 1024 || ws_size < WS_END) { fprintf(stderr, "kernel_launch: unexpected shapes (n_in %d out %d ws %zu need %zu)\n", n_in, out_size, ws_size, (size_t)WS_END); grid = -1; return; }
        int dev = 0, cus = 0, per_cu = 0;
        hipGetDevice(&dev); hipDeviceGetAttribute(&cus, hipDeviceAttributeMultiprocessorCount, dev);
        hipFuncSetAttribute((const void*)fwd_mega, hipFuncAttributeMaxDynamicSharedMemorySize, LDS_BYTES);
        hipOccupancyMaxActiveBlocksPerMultiprocessor(&per_cu, (const void*)fwd_mega, 512, LDS_BYTES);
        if (per_cu < 1) { fprintf(stderr, "kernel_launch: occupancy query says %d blocks per CU\n", per_cu); per_cu = 1; }
        (void)hipGetLastError();
        grid = cus;
    }
    if (grid < 0) return;
    if (hipMemsetAsync((char*)d_ws + WS_BAR, 0, XCD_BAR_WORDS * 4, stream) != hipSuccess) { fprintf(stderr, "kernel_launch: memset of the barrier words failed\n"); return; }
    Params p{};
    for (int i = 0; i < 21; ++i) p.in[i] = (const float*)d_in[i];
    p.out = (float*)d_out; p.ws = (unsigned char*)d_ws;
#if PER_PHASE_LAUNCH
    for (int ph = 0; ph < NPHASE; ++ph) { p.ph_lo = ph; p.ph_hi = ph + 1; hipLaunchKernelGGL(fwd_mega, dim3(grid), dim3(512), LDS_BYTES, stream, p); }
#else
    p.ph_lo = 0; p.ph_hi = NPHASE;
    void* args[] = {&p};
    hipError_t e = hipLaunchCooperativeKernel((const void*)fwd_mega, dim3(grid), dim3(512), args, LDS_BYTES, stream);
    if (e != hipSuccess) fprintf(stderr, "cooperative launch failed: %s (grid %d)\n", hipGetErrorString(e), grid);
#endif
}
```

```cpp
#include <hip/hip_runtime.h>
#include <hip/hip_cooperative_groups.h>
#include <cstdio>
namespace cg = cooperative_groups;

#ifndef PHASE_MASK
#define PHASE_MASK 0x1fff
#endif
#define PHON(k) ((PHASE_MASK >> (k)) & 1)
#ifndef PER_PHASE_LAUNCH
#define PER_PHASE_LAUNCH 0
#endif

#define LAS __attribute__((address_space(3)))
#define DEV __device__ __forceinline__
#define OPQV(x) asm volatile("" : "+v"(x))
#define OPQS(x) asm volatile("" : "+s"(x))
typedef unsigned short bf16_t;
typedef short bf16x8 __attribute__((ext_vector_type(8)));
typedef float f32x4 __attribute__((ext_vector_type(4)));
typedef unsigned u32x4 __attribute__((ext_vector_type(4)));
typedef unsigned u32x2 __attribute__((ext_vector_type(2)));

constexpr int T_ = 16384, S_ = 2048, NP = 11008, NIN = 10800, DFF = 3072;
constexpr int COL_GB = 0, COL_GC = 1024, COL_VA = 2048, COL_Q = 3072, COL_KC = 4096, COL_VC = 4352, COL_KS = 4608, COL_VS = 4864,
              COL_KW = 5120, COL_VW = 5376, COL_U = 5632, COL_V = 6656, COL_G0 = 7680, COL_GN = 10752;
constexpr float EPS_ = 1e-6f, SCALE_ = 0.125f, NEG_ = -1e30f, LOG2E_ = 1.4426950408889634f, QSC_ = 0.125f * 1.4426950408889634f;
constexpr int LDS_EX = 131072 + 16;
constexpr int LDS_BYTES = 131072 + 16 + 1024;
constexpr int NPHASE = 41;

constexpr size_t WS_WIN = 0;
constexpr size_t WS_WBR = WS_WIN + (size_t)NP * 1024 * 2;
constexpr size_t WS_WO = WS_WBR + (size_t)3072 * 1024 * 2;
constexpr size_t WS_WUP = WS_WO + (size_t)1024 * 1024 * 2;
constexpr size_t WS_WDN = WS_WUP + (size_t)6144 * 1024 * 2;
constexpr size_t WS_W1T = WS_WDN + (size_t)1024 * 3072 * 2;
constexpr size_t WS_W2T = WS_W1T + (size_t)2 * 128 * 2048 * 2;
constexpr size_t WS_KC = WS_W2T + (size_t)2 * 64 * 128 * 2;
constexpr size_t WS_VC = WS_KC + (size_t)32 * 128 * 64 * 2;
constexpr size_t WS_H = WS_VC + (size_t)32 * 128 * 64 * 2;
constexpr size_t WS_P = WS_H + (size_t)T_ * 1024 * 2;
constexpr size_t WS_O3 = WS_P + (size_t)T_ * NP * 2;
constexpr size_t WS_MF = WS_O3 + (size_t)3 * T_ * 1024 * 2;
constexpr size_t WS_KV = WS_MF + 4096;
constexpr size_t WS_X = WS_MF + (size_t)T_ * 1024 * 4;
constexpr size_t WS_QB = WS_X + (size_t)T_ * 1024 * 2;
constexpr size_t WS_GLA = WS_QB + (size_t)T_ * 1024 * 2;
constexpr size_t WS_GFA = WS_GLA + (size_t)64 * 2 * 1024 * 4;
constexpr size_t WS_END = WS_GFA + (size_t)64 * 2 * 2 * 1024 * 4;
constexpr size_t WS_BAR = WS_MF + (size_t)60 * 1048576;
constexpr size_t WS_GL = WS_MF + (size_t)52 * 1048576;
constexpr size_t WS_GF = WS_GL + (size_t)64 * 2 * DFF * 4;
constexpr size_t KV_TENSOR = (size_t)8 * 4 * S_ * 64;

struct Params { const float* in[21]; float* out; unsigned char* ws; int ph_lo, ph_hi; };

DEV float bf2f(unsigned b) { return __uint_as_float(b << 16); }
DEV float bflo(unsigned u) { return __uint_as_float(u << 16); }
DEV float bfhi(unsigned u) { return __uint_as_float(u & 0xffff0000u); }
DEV unsigned cvt_pk_bf16(float lo, float hi) { unsigned r; asm volatile("v_cvt_pk_bf16_f32 %0, %1, %2" : "=v"(r) : "v"(lo), "v"(hi)); return r; }
DEV float gelu_t(float x) { const float u = x * (0.7978845608f + 0.0356774081f * x * x); return x * __builtin_amdgcn_rcpf(1.f + __builtin_amdgcn_exp2f(-2.885390082f * u)); }
DEV float sigm(float x) { return __builtin_amdgcn_rcpf(1.f + __builtin_amdgcn_exp2f(-1.4426950409f * x)); }
DEV void unpack8(const u32x4 v, float (&f)[8]) { f[0] = bflo(v.x); f[1] = bfhi(v.x); f[2] = bflo(v.y); f[3] = bfhi(v.y); f[4] = bflo(v.z); f[5] = bfhi(v.z); f[6] = bflo(v.w); f[7] = bfhi(v.w); }
DEV u32x4 pack8(const float (&f)[8]) { u32x4 w; w.x = cvt_pk_bf16(f[0], f[1]); w.y = cvt_pk_bf16(f[2], f[3]); w.z = cvt_pk_bf16(f[4], f[5]); w.w = cvt_pk_bf16(f[6], f[7]); return w; }
DEV u32x4 pair32(u32x2 a, u32x2 b) {
    const auto r0 = __builtin_amdgcn_permlane32_swap(a.x, b.x, false, false); const auto r1 = __builtin_amdgcn_permlane32_swap(a.y, b.y, false, false);
    return (u32x4){r0[0], r1[0], r0[1], r1[1]};
}
DEV bf16x8 as_bf16x8(u32x4 v) { union { u32x4 u; bf16x8 b; } x; x.u = v; return x.b; }

namespace pg8 {
constexpr int BM = 256, BK = 64, HALF = 128, HTB = HALF * BK * 2, NXCD = 8, WGM = 8;
DEV int lds_byte(int r, int c) { const int st = (r >> 4) * 2 + (c >> 5), rr = r & 15, cc = c & 31, ob = rr * 64 + cc * 2; return st * 1024 + (ob ^ (((ob >> 9) & 1) << 5)); }
DEV void stage_rc(int b, int& R, int& C) { const int st = b / 1024, sb = b % 1024, swz = sb ^ (((sb >> 9) & 1) << 5); R = (st >> 1) * 16 + swz / 64; C = (st & 1) * 32 + (swz % 64) / 2; }
DEV int perm32(int rho) { const int n = rho >> 4, i = rho & 15; return 8 * (i >> 2) + 4 * n + (i & 3); }
struct Unit { int pm, pn; };
struct Gemm { const bf16_t* A; const bf16_t* Bt; int M, N, K; };

struct StaticOrder {
    int nM, nN, nwg, G, c;
    DEV void init(int M, int N, int G_, int c_) { nM = M / BM; nN = N / BM; nwg = nM * nN; G = G_; c = c_; }
    DEV bool tile(long L, Unit& u) const {
        if (L >= nwg) return false;
        int wgid = (int)L; { const int q = nwg / NXCD, r = nwg % NXCD, xcd = wgid % NXCD, off = wgid / NXCD; wgid = (xcd < r ? xcd * (q + 1) : r * (q + 1) + (xcd - r) * q) + off; }
        const int nig = WGM * nN, gid = wgid / nig, fm = gid * WGM, gsz = (nM - fm) < WGM ? (nM - fm) : WGM;
        u.pm = fm + ((wgid % nig) % gsz); u.pn = (wgid % nig) / gsz; return true;
    }
    DEV bool next(int i, Unit& u) const { return tile((long)i * G + c, u); }
};
struct BranchOrder {
    StaticOrder so;
    DEV void init(int G_, int c_) { so.init(T_, 1024, G_, c_); }
    DEV bool next(int i, Unit& u) const { const int round = i / 3, br = i - round * 3; Unit t; if (!so.tile((long)round * so.G + so.c, t)) return false; u.pm = br * 64 + t.pm; u.pn = br * 4 + t.pn; return true; }
};

struct EpiProj {
    static constexpr bool PERM = true, ROWPERM = true;
    bf16_t* O; int ldc; int act_mode; bf16_t* KV; bf16_t* OA; bf16_t* QB; const float* cwa; float* GLA; float* GFA; LAS unsigned char* ex;
    DEV bool operator()(f32x4 (&acc)[2][2][4][2], const Unit& u, int wr, int wc, int fr, int fq) const {
        const int row0 = u.pm * BM + (16 * wr + fr) * 8, col0 = u.pn * BM + wc * 32 + 8 * fq;
        const int act = act_mode ? 0 : (u.pn < 22 ? 0 : (u.pn < 26 ? 1 : 2));
        const bool kvt = !act_mode && u.pn >= 16 && u.pn < 22;
        if (!act_mode && u.pn >= 26 && u.pn < 42) {
            const int chb = (u.pn - 26) * 64 + wc * 16 + (fq & 1) * 8, up = fq >> 1;
#pragma unroll
            for (int ai = 0; ai < 2; ++ai)
#pragma unroll
                for (int mp = 0; mp < 2; ++mp) { u32x2 pk[2][4];
#pragma unroll
                    for (int mm = 0; mm < 2; ++mm) { const int m = mp * 2 + mm; float f0[4], f1[4], f2[4], uu[4];
#pragma unroll
                        for (int j = 0; j < 4; ++j) { const float s0 = sigm(acc[ai][0][m][0][j]), s1 = fmaxf(sigm(acc[ai][0][m][1][j]), 1e-12f), s2 = fmaxf(sigm(acc[ai][1][m][0][j]), 1e-12f);
                            f0[j] = s0 * __builtin_amdgcn_rcpf(s1); f1[j] = s1 * __builtin_amdgcn_rcpf(s2); f2[j] = s2; uu[j] = gelu_t(acc[ai][1][m][1][j]); }
                        pk[mm][0].x = cvt_pk_bf16(f0[0], f0[1]); pk[mm][0].y = cvt_pk_bf16(f0[2], f0[3]); pk[mm][1].x = cvt_pk_bf16(f1[0], f1[1]); pk[mm][1].y = cvt_pk_bf16(f1[2], f1[3]);
                        pk[mm][2].x = cvt_pk_bf16(f2[0], f2[1]); pk[mm][2].y = cvt_pk_bf16(f2[2], f2[3]); pk[mm][3].x = cvt_pk_bf16(uu[0], uu[1]); pk[mm][3].y = cvt_pk_bf16(uu[2], uu[3]); }
                    bf16_t* rp = O + (size_t)(row0 + ai * 4 + mp * 2 + up) * ldc + chb;
                    *(u32x4*)(rp + COL_G0) = pair32(pk[0][0], pk[1][0]);
                    *(u32x4*)(rp + COL_G0 + 1024) = pair32(pk[0][1], pk[1][1]);
                    *(u32x4*)(rp + COL_G0 + 2048) = pair32(pk[0][2], pk[1][2]);
                    *(u32x4*)(rp + COL_U) = pair32(pk[0][3], pk[1][3]); }
            return true;
        }
        if (!act_mode && u.pn < 16) {
            const int ch0 = u.pn * 64 + wc * 16 + (fq & 1) * 8 + (fq >> 1) * 4, chb = u.pn * 64 + wc * 16 + (fq & 1) * 8, up = fq >> 1;
            f32x4 w[3];
#pragma unroll
            for (int k = 0; k < 3; ++k) w[k] = *(const f32x4*)(cwa + k * 1024 + ch0);
            f32x4 xp[8];
#pragma unroll
            for (int i = 0; i < 8; ++i) xp[i] = acc[i >> 2][0][i & 3][1] * acc[i >> 2][1][i & 3][0];
            f32x4 p6, p7;
#pragma unroll
            for (int c = 0; c < 4; ++c) { p6[c] = __shfl_up(xp[6][c], 1); p7[c] = __shfl_up(xp[7][c], 1); }
            LAS f32x4* EX = (LAS f32x4*)ex + (wc * 4 + fq) * 2;
            if (wr == 0 && fr == 15) { EX[0] = xp[6]; EX[1] = xp[7]; asm volatile("s_waitcnt lgkmcnt(0)" ::: "memory"); }
            if (wr == 1 && fr == 0) { p6 = EX[0]; p7 = EX[1]; }
            if (wr == 1 && fr == 15) { float* gl = GLA + (size_t)u.pm * 2 * 1024 + ch0; *(f32x4*)gl = xp[6]; *(f32x4*)(gl + 1024) = xp[7]; }
            const bool halo = (wr == 0 && fr == 0);
            if (halo) {
#pragma unroll
                for (int t = 0; t < 2; ++t) { float* gf = GFA + ((size_t)(u.pm * 2 + t) * 2) * 1024 + ch0; *(f32x4*)gf = acc[0][0][t][0]; *(f32x4*)(gf + 1024) = xp[t]; } }
#pragma unroll
            for (int ip = 0; ip < 4; ++ip) { u32x2 o[2], q2[2];
#pragma unroll
                for (int ii = 0; ii < 2; ++ii) { const int i = ip * 2 + ii;
                    const f32x4 xm1 = i >= 1 ? xp[i >= 1 ? i - 1 : 0] : p7, xm2 = i >= 2 ? xp[i >= 2 ? i - 2 : 0] : (i == 0 ? p6 : p7);
                    const f32x4 y = acc[i >> 2][0][i & 3][0] * (w[0] * xm2 + w[1] * xm1 + w[2] * xp[i]);
                    o[ii].x = cvt_pk_bf16(y[0], y[1]); o[ii].y = cvt_pk_bf16(y[2], y[3]);
                    const f32x4 qv = acc[i >> 2][1][i & 3][1];
                    q2[ii].x = cvt_pk_bf16(qv[0], qv[1]); q2[ii].y = cvt_pk_bf16(qv[2], qv[3]); }
                const size_t tok = (size_t)(row0 + ip * 2 + up);
                const u32x4 ow = pair32(o[0], o[1]), qw = pair32(q2[0], q2[1]);
                if (!(halo && ip == 0)) *(u32x4*)(OA + tok * 1024 + chb) = ow;
                *(u32x4*)(QB + tok * 1024 + chb) = qw; }
            return true;
        }
#pragma unroll
        for (int ai = 0; ai < 2; ++ai)
#pragma unroll
            for (int m = 0; m < 4; ++m) { const int row = row0 + ai * 4 + m; bf16_t* rowp = O + (size_t)row * ldc + col0 + ((!act_mode && u.pn >= 22 && u.pn < 26) ? 1024 : 0);
                if (kvt) rowp = KV + (size_t)(u.pn - 16) * KV_TENSOR + ((size_t)((row >> 11) * 4) * S_ + (row & (S_ - 1))) * 64 + (size_t)(wc >> 1) * S_ * 64 + (wc & 1) * 32 + 8 * fq;
#pragma unroll
                for (int bj = 0; bj < 2; ++bj) { float v[8];
#pragma unroll
                    for (int j = 0; j < 4; ++j) { v[j] = acc[ai][bj][m][0][j]; v[4 + j] = acc[ai][bj][m][1][j]; }
                    if (act == 1) {
#pragma unroll
                        for (int j = 0; j < 8; ++j) v[j] = gelu_t(v[j]); }
                    else if (act == 2) {
#pragma unroll
                        for (int j = 0; j < 8; ++j) v[j] = sigm(v[j]); }
                    *(u32x4*)(rowp + (kvt ? (size_t)bj * 2 * S_ * 64 : (size_t)bj * HALF)) = pack8(v); } }
        return true;
    }
};
struct EpiBranch {
    static constexpr bool PERM = true, ROWPERM = false;
    const bf16_t* P; bf16_t* MB;
    DEV bool operator()(f32x4 (&acc)[2][2][4][2], const Unit& u, int wr, int wc, int fr, int fq) const {
        const int br = u.pn >> 2, pn = u.pn & 3, pm = u.pm - br * 64;
        const int row0 = pm * BM + wr * 64 + fr, col0 = pn * BM + wc * 32 + 8 * fq;
#pragma unroll
        for (int ai = 0; ai < 2; ++ai) {
            u32x4 ga[4][2];
#pragma unroll
            for (int m = 0; m < 4; ++m)
#pragma unroll
                for (int bj = 0; bj < 2; ++bj) ga[m][bj] = *(const u32x4*)(P + (size_t)(row0 + ai * HALF + m * 16) * NP + COL_G0 + br * 1024 + col0 + bj * HALF);
#pragma unroll
            for (int m = 0; m < 4; ++m)
#pragma unroll
                for (int bj = 0; bj < 2; ++bj) { const size_t row = (size_t)(row0 + ai * HALF + m * 16);
                    float f[8], v[8]; unpack8(ga[m][bj], f);
#pragma unroll
                    for (int j = 0; j < 4; ++j) { v[j] = acc[ai][bj][m][0][j] * f[j]; v[4 + j] = acc[ai][bj][m][1][j] * f[4 + j]; }
                    if (br < 2) { acc[ai][bj][m][0] = (f32x4){v[0], v[1], v[2], v[3]}; acc[ai][bj][m][1] = (f32x4){v[4], v[5], v[6], v[7]}; }
                    else *(u32x4*)(MB + row * 1024 + col0 + bj * HALF) = pack8(v); }
        }
        return br == 2;
    }
};
struct EpiRes {
    static constexpr bool PERM = true, ROWPERM = false;
    bf16_t* X;
    DEV bool operator()(f32x4 (&acc)[2][2][4][2], const Unit& u, int wr, int wc, int fr, int fq) const {
        const int row0 = u.pm * BM + wr * 64 + fr, col0 = u.pn * BM + wc * 32 + 8 * fq;
#pragma unroll
        for (int ai = 0; ai < 2; ++ai) {
            u32x4 old[4][2];
#pragma unroll
            for (int m = 0; m < 4; ++m)
#pragma unroll
                for (int bj = 0; bj < 2; ++bj) old[m][bj] = *(const u32x4*)(X + (size_t)(row0 + ai * HALF + m * 16) * 1024 + col0 + bj * HALF);
#pragma unroll
            for (int m = 0; m < 4; ++m)
#pragma unroll
                for (int bj = 0; bj < 2; ++bj) { float v[8]; unpack8(old[m][bj], v);
#pragma unroll
                    for (int j = 0; j < 4; ++j) { v[j] += acc[ai][bj][m][0][j]; v[4 + j] += acc[ai][bj][m][1][j]; }
                    *(u32x4*)(X + (size_t)(row0 + ai * HALF + m * 16) * 1024 + col0 + bj * HALF) = pack8(v); }
        }
        return true;
    }
};
struct EpiAct {
    static constexpr bool PERM = true, ROWPERM = true;
    bf16_t* ACT; const float* cw; float* GL; float* GF; LAS unsigned char* ex;
    DEV bool operator()(f32x4 (&acc)[2][2][4][2], const Unit& u, int wr, int wc, int fr, int fq) const {
        const int ch0 = u.pn * 128 + wc * 32 + 8 * fq;
        float w[3][8];
#pragma unroll
        for (int k = 0; k < 3; ++k) { const f32x4 w0 = *(const f32x4*)(cw + k * DFF + ch0), w1 = *(const f32x4*)(cw + k * DFF + ch0 + 4);
#pragma unroll
            for (int j = 0; j < 4; ++j) { w[k][j] = w0[j]; w[k][4 + j] = w1[j]; } }
        float p6[8], p7[8];
#pragma unroll
        for (int c = 0; c < 8; ++c) { p6[c] = __shfl_up(acc[1][0][2][c >> 2][c & 3], 1); p7[c] = __shfl_up(acc[1][0][3][c >> 2][c & 3], 1); }
        LAS float* EX = (LAS float*)ex + (wc * 4 + fq) * 16;
        if (wr == 0 && fr == 15) {
#pragma unroll
            for (int c = 0; c < 8; ++c) { EX[c] = acc[1][0][2][c >> 2][c & 3]; EX[8 + c] = acc[1][0][3][c >> 2][c & 3]; }
            asm volatile("s_waitcnt lgkmcnt(0)" ::: "memory");
        }
        if (wr == 1 && fr == 0) {
#pragma unroll
            for (int c = 0; c < 8; ++c) { p6[c] = EX[c]; p7[c] = EX[8 + c]; } }
        if (wr == 1 && fr == 15) { float* gl = GL + (size_t)u.pm * 2 * DFF + ch0;
            *(f32x4*)gl = acc[1][0][2][0]; *(f32x4*)(gl + 4) = acc[1][0][2][1]; *(f32x4*)(gl + DFF) = acc[1][0][3][0]; *(f32x4*)(gl + DFF + 4) = acc[1][0][3][1]; }
        const bool halo = (wr == 0 && fr == 0);
        if (halo) {
#pragma unroll
            for (int t = 0; t < 2; ++t) { float* gf = GF + ((size_t)(u.pm * 2 + t) * 2) * DFF + ch0;
                *(f32x4*)gf = acc[0][0][t][0]; *(f32x4*)(gf + 4) = acc[0][0][t][1]; *(f32x4*)(gf + DFF) = acc[0][1][t][0]; *(f32x4*)(gf + DFF + 4) = acc[0][1][t][1]; } }
        bf16_t* outp = ACT + ((size_t)u.pm * BM + (size_t)(16 * wr + fr) * 8) * DFF + ch0;
#pragma unroll
        for (int i = 0; i < 8; ++i) { float y[8];
#pragma unroll
            for (int c = 0; c < 8; ++c) {
                const float g0 = acc[i >> 2][0][i & 3][c >> 2][c & 3];
                const float gm1 = i >= 1 ? acc[(i - 1 < 0 ? 0 : i - 1) >> 2][0][(i - 1 < 0 ? 0 : i - 1) & 3][c >> 2][c & 3] : p7[c];
                const float gm2 = i >= 2 ? acc[(i - 2 < 0 ? 0 : i - 2) >> 2][0][(i - 2 < 0 ? 0 : i - 2) & 3][c >> 2][c & 3] : (i == 0 ? p6[c] : p7[c]);
                y[c] = gelu_t(w[0][c] * gm2 + w[1][c] * gm1 + w[2][c] * g0) * acc[i >> 2][1][i & 3][c >> 2][c & 3]; }
            if (!(halo && i < 2)) *(u32x4*)(outp + (size_t)i * DFF) = pack8(y); }
        return true;
    }
};

template <class Epi, class Sched>
DEV void gemm_phase(LAS unsigned char* lds, const Gemm g, const Sched& S, const Epi& E) {
    int tid = threadIdx.x; OPQV(tid);
    const int wid = __builtin_amdgcn_readfirstlane(tid >> 6), lane = tid & 63, wr = wid >> 2, wc = wid & 3, fr = lane & 15, fq = lane >> 4;
    const int K = g.K, nt = K / BK;
    unsigned voffA[2], voffB[2];
#pragma unroll
    for (int i = 0; i < 2; ++i) { int R, C; stage_rc(tid * 16 + i * 8192, R, C); const int Rb = Epi::PERM ? ((R & ~31) + perm32(R & 31)) : R;
        const int Ra = Epi::ROWPERM ? (((R >> 6) * 16 + (R & 15)) * 8 + ((R >> 4) & 3)) : R;
        voffA[i] = (unsigned)(Ra * K + C) * 2u; voffB[i] = (unsigned)(Rb * K + C) * 2u; }
    const size_t kstep = (size_t)(BK * 2);
    const size_t hstep = (size_t)HALF * K * 2;
    const size_t hstepA = Epi::ROWPERM ? (size_t)4 * K * 2 : hstep;
    const size_t tstep = 2 * hstep;
    const unsigned ldsw = (unsigned)wid * 1024u;
    const int aoff = lds_byte(wr * 64 + fr, fq * 8), boff = lds_byte(wc * 32 + fr, fq * 8);
#define PG8_SA(b, h) (((b) * 2 + (h)) * HTB)
#define PG8_SB(b, h) ((4 + (b) * 2 + (h)) * HTB)
#define PG8_STAGE(bufoff, gbase, voff) do { _Pragma("unroll") for (int _i = 0; _i < 2; ++_i) \
        __builtin_amdgcn_global_load_lds((const unsigned*)((const char*)(gbase) + (voff)[_i]), (LAS unsigned*)(lds + (bufoff) + ldsw + _i * 8192), 16, 0, 0); } while (0)
#define PG8_LDA(dst, b, h) do { _Pragma("unroll") for (int m = 0; m < 4; ++m) _Pragma("unroll") for (int k = 0; k < 2; ++k) dst[m][k] = *(const LAS bf16x8*)(lds + PG8_SA(b, h) + aoff + m * 2048 + k * 1024); } while (0)
#define PG8_LDB(dst, b, h) do { _Pragma("unroll") for (int n = 0; n < 2; ++n) _Pragma("unroll") for (int k = 0; k < 2; ++k) dst[n][k] = *(const LAS bf16x8*)(lds + PG8_SB(b, h) + boff + n * 2048 + k * 1024); } while (0)
#define PG8_MMA(ai, bj, At, Bt) do { __builtin_amdgcn_s_setprio(1); _Pragma("unroll") for (int m = 0; m < 4; ++m) _Pragma("unroll") for (int n = 0; n < 2; ++n) _Pragma("unroll") for (int k = 0; k < 2; ++k) \
        acc[ai][bj][m][n] = __builtin_amdgcn_mfma_f32_16x16x32_bf16(Bt[n][k], At[m][k], acc[ai][bj][m][n], 0, 0, 0); __builtin_amdgcn_s_setprio(0); } while (0)
#define PG8_WAIT_V(n) asm volatile("s_waitcnt vmcnt(" #n ")" ::: "memory")
#define PG8_WAIT_L(n) asm volatile("s_waitcnt lgkmcnt(" #n ")" ::: "memory")
#define PG8_BAR __builtin_amdgcn_s_barrier()
#define PG8_SCHED __builtin_amdgcn_sched_barrier(0)
    Unit cur, nxt; int ui = 0;
    if (!S.next(0, cur)) return;
    f32x4 acc[2][2][4][2];
#pragma unroll
    for (int a = 0; a < 2; ++a)
#pragma unroll
        for (int b = 0; b < 2; ++b)
#pragma unroll
            for (int m = 0; m < 4; ++m)
#pragma unroll
                for (int n = 0; n < 2; ++n) acc[a][b][m][n] = (f32x4){0.f, 0.f, 0.f, 0.f};
    bf16x8 At[4][2], B0[2][2], B1[2][2];
    const char* cA = (const char*)g.A + (size_t)cur.pm * tstep; const char* cB = (const char*)g.Bt + (size_t)cur.pn * tstep;
    PG8_STAGE(PG8_SB(0, 0), cB, voffB); PG8_STAGE(PG8_SB(0, 1), cB + hstep, voffB); PG8_STAGE(PG8_SA(0, 0), cA, voffA); PG8_STAGE(PG8_SA(0, 1), cA + hstepA, voffA);
    if (wr == 1) PG8_BAR;
    PG8_WAIT_V(2); PG8_BAR;
    PG8_STAGE(PG8_SB(1, 0), cB + kstep, voffB); PG8_STAGE(PG8_SA(1, 0), cA + kstep, voffA); PG8_STAGE(PG8_SB(1, 1), cB + hstep + kstep, voffB);
    PG8_WAIT_V(6); PG8_BAR;
    for (;;) {
        const bool has_next = S.next(ui + 1, nxt);
        const char* nA = has_next ? (const char*)g.A + (size_t)nxt.pm * tstep : cA; const char* nB = has_next ? (const char*)g.Bt + (size_t)nxt.pn * tstep : cB;
        for (int t = 0; t < nt; t += 2) {
            const bool last = (t == nt - 2);
            const char* a1 = cA + (size_t)(t + 1) * kstep;
            const char* a2 = last ? nA : cA + (size_t)(t + 2) * kstep; const char* b2 = last ? nB : cB + (size_t)(t + 2) * kstep;
            const char* a3 = a2 + kstep; const char* b3 = b2 + kstep;
            PG8_LDB(B0, 0, 0); PG8_LDB(B1, 0, 1); PG8_SCHED; PG8_LDA(At, 0, 0); PG8_STAGE(PG8_SA(1, 1), a1 + hstepA, voffA);
            PG8_WAIT_V(8); PG8_WAIT_L(0); PG8_BAR; PG8_MMA(0, 0, At, B0); PG8_MMA(0, 1, At, B1); PG8_BAR; PG8_SCHED;
            PG8_LDA(At, 0, 1); PG8_STAGE(PG8_SB(0, 0), b2, voffB); PG8_STAGE(PG8_SB(0, 1), b2 + hstep, voffB); PG8_STAGE(PG8_SA(0, 0), a2, voffA);
            PG8_WAIT_V(8); PG8_WAIT_L(0); PG8_BAR; PG8_MMA(1, 0, At, B0); PG8_MMA(1, 1, At, B1); PG8_BAR; PG8_SCHED;
            PG8_LDB(B0, 1, 0); PG8_LDB(B1, 1, 1); PG8_SCHED; PG8_LDA(At, 1, 0); PG8_STAGE(PG8_SA(0, 1), a2 + hstepA, voffA);
            PG8_WAIT_V(8); PG8_WAIT_L(0); PG8_BAR; PG8_MMA(0, 0, At, B0); PG8_MMA(0, 1, At, B1); PG8_BAR; PG8_SCHED;
            PG8_LDA(At, 1, 1); PG8_STAGE(PG8_SB(1, 0), b3, voffB); PG8_STAGE(PG8_SB(1, 1), b3 + hstep, voffB); PG8_STAGE(PG8_SA(1, 0), a3, voffA);
            PG8_WAIT_V(8); PG8_WAIT_L(0); PG8_BAR; PG8_MMA(1, 0, At, B0); PG8_MMA(1, 1, At, B1); PG8_BAR; PG8_SCHED;
        }
        const bool rst = E(acc, cur, wr, wc, fr, fq);
        if (!has_next) break;
        if (rst) {
#pragma unroll
        for (int a = 0; a < 2; ++a)
#pragma unroll
            for (int b = 0; b < 2; ++b)
#pragma unroll
                for (int m = 0; m < 4; ++m)
#pragma unroll
                    for (int n = 0; n < 2; ++n) acc[a][b][m][n] = (f32x4){0.f, 0.f, 0.f, 0.f}; }
        cur = nxt; cA = nA; cB = nB; ++ui;
    }
    PG8_WAIT_V(0);
    if (wr == 0) PG8_BAR;
    PG8_BAR;
#undef PG8_SA
#undef PG8_SB
#undef PG8_STAGE
#undef PG8_LDA
#undef PG8_LDB
#undef PG8_MMA
#undef PG8_WAIT_V
#undef PG8_WAIT_L
#undef PG8_BAR
#undef PG8_SCHED
}
}

DEV int map_col(int n, int Nsrc, int mode) {
    if (mode == 1) { if (n < 4096) { const int U = n >> 8, c = n & 255; const int fq = (c >> 3) & 3; const int t = (c >> 7) * 2 + ((c >> 2) & 1), ch = 64 * U + ((c >> 5) & 3) * 16 + (fq & 1) * 8 + (fq >> 1) * 4 + (c & 3); return t * 1024 + ch; }
        if (n < 5632) return n;
        if (n < 6656) return 6704 + (n - 5632);
        if (n < 10752) { const int m = n - 6656, U = m >> 8, c = m & 255;
            const int fq = (c >> 3) & 3; const int t = (c >> 7) * 2 + ((c >> 2) & 1), ch = 64 * U + ((c >> 5) & 3) * 16 + (fq & 1) * 8 + (fq >> 1) * 4 + (c & 3);
            return (t == 0 ? 7728 : t == 1 ? 8752 : t == 2 ? 9776 : 5680) + ch; }
        if (n < 10800) return n - 5120; return -1; }
    if (mode == 2) { const int pn = n >> 8, r = n & 255; return r < 128 ? 128 * pn + r : 3072 + 128 * pn + (r - 128); }
    return n < Nsrc ? n : -1;
}
DEV void lds_barrier() { asm volatile("s_waitcnt lgkmcnt(0)" ::: "memory"); __builtin_amdgcn_s_barrier(); asm volatile("" ::: "memory"); }
template <int NW>
DEV void convT(LAS unsigned char* lds, const float* src, int K, int Nsrc, bf16_t* dst, int Npad, int mode, int rot) {
    LAS float* tile = (LAS float*)lds;
    int tid = threadIdx.x; OPQV(tid); const int G = gridDim.x;
    constexpr int PW = NW + 1, NL = NW * 64 / 512, RPI = 512 / NW, TPN = 512 / NW, KS = 64 / TPN;
    const int ntk = K / 64, ntn = Npad / NW, ntiles = ntk * ntn;
    const int n = tid % NW, kr = tid / NW;
    int tix = (blockIdx.x + G - (rot % G)) % G;
    float ld[NL];
    if (tix < ntiles) { const int n0 = (tix / ntk) * NW, k0 = (tix % ntk) * 64; const int sc = map_col(n0 + n, Nsrc, mode);
#pragma unroll
        for (int i = 0; i < NL; ++i) ld[i] = sc >= 0 ? __builtin_nontemporal_load(src + (size_t)(k0 + i * RPI + kr) * Nsrc + sc) : 0.f; }
    for (; tix < ntiles; tix += G) {
        const int n0 = (tix / ntk) * NW, k0 = (tix % ntk) * 64;
#pragma unroll
        for (int i = 0; i < NL; ++i) tile[(i * RPI + kr) * PW + n] = ld[i];
        lds_barrier();
        const int tnx = tix + G;
        if (tnx < ntiles) { const int n1 = (tnx / ntk) * NW, k1 = (tnx % ntk) * 64; const int sc = map_col(n1 + n, Nsrc, mode);
#pragma unroll
            for (int i = 0; i < NL; ++i) ld[i] = sc >= 0 ? __builtin_nontemporal_load(src + (size_t)(k1 + i * RPI + kr) * Nsrc + sc) : 0.f; }
        { const int nn = tid / TPN, ks = (tid % TPN) * KS;
#pragma unroll
            for (int h = 0; h < KS / 8; ++h) { float v[8];
#pragma unroll
                for (int j = 0; j < 8; ++j) v[j] = tile[(ks + h * 8 + j) * PW + nn];
                *(u32x4*)(dst + (size_t)(n0 + nn) * K + k0 + ks + h * 8) = pack8(v); } }
        lds_barrier();
    }
}
DEV float wave_sum(float v) {
#pragma unroll
    for (int o = 32; o >= 1; o >>= 1) v += __shfl_xor(v, o);
    return v;
}
template <int RB>
DEV void rmsnorm_rows(const float* srcf, const bf16_t* srcb, const float* gamma, bf16_t* H, bf16_t* cpy, float* outn, int row0, int lane) {
    float v[RB][16];
    if (srcf) {
#pragma unroll
        for (int r = 0; r < RB; ++r)
#pragma unroll
            for (int hf = 0; hf < 2; ++hf) { const f32x4 a = *(const f32x4*)(srcf + (size_t)(row0 + r) * 1024 + hf * 512 + lane * 8), b2 = *(const f32x4*)(srcf + (size_t)(row0 + r) * 1024 + hf * 512 + lane * 8 + 4);
#pragma unroll
                for (int j = 0; j < 4; ++j) { v[r][hf * 8 + j] = a[j]; v[r][hf * 8 + 4 + j] = b2[j]; } }
    } else {
        u32x4 raw[RB][2];
#pragma unroll
        for (int r = 0; r < RB; ++r)
#pragma unroll
            for (int hf = 0; hf < 2; ++hf) raw[r][hf] = *(const u32x4*)(srcb + (size_t)(row0 + r) * 1024 + hf * 512 + lane * 8);
#pragma unroll
        for (int r = 0; r < RB; ++r)
#pragma unroll
            for (int hf = 0; hf < 2; ++hf) { float t8[8]; unpack8(raw[r][hf], t8);
#pragma unroll
                for (int j = 0; j < 8; ++j) v[r][hf * 8 + j] = t8[j]; }
    }
    f32x4 g0[2], g1[2];
#pragma unroll
    for (int hf = 0; hf < 2; ++hf) { g0[hf] = *(const f32x4*)(gamma + hf * 512 + lane * 8); g1[hf] = *(const f32x4*)(gamma + hf * 512 + lane * 8 + 4); }
#pragma unroll
    for (int r = 0; r < RB; ++r) {
        float ss = 0.f;
#pragma unroll
        for (int j = 0; j < 16; ++j) ss += v[r][j] * v[r][j];
        ss = wave_sum(ss);
        const float rs = rsqrtf(ss * (1.f / 1024.f) + EPS_);
        const int row = row0 + r;
#pragma unroll
        for (int hf = 0; hf < 2; ++hf) { const int c = hf * 512 + lane * 8;
            float y[8], x8[8];
#pragma unroll
            for (int j = 0; j < 4; ++j) { y[j] = v[r][hf * 8 + j] * rs * g0[hf][j]; y[4 + j] = v[r][hf * 8 + 4 + j] * rs * g1[hf][j]; }
#pragma unroll
            for (int j = 0; j < 8; ++j) x8[j] = v[r][hf * 8 + j];
            if (cpy) *(u32x4*)(cpy + (size_t)row * 1024 + c) = pack8(x8);
            if (outn) { *(f32x4*)(outn + (size_t)row * 1024 + c) = (f32x4){y[0], y[1], y[2], y[3]}; *(f32x4*)(outn + (size_t)row * 1024 + c + 4) = (f32x4){y[4], y[5], y[6], y[7]}; }
            if (H) *(u32x4*)(H + (size_t)row * 1024 + c) = pack8(y); }
    }
}
DEV void phase_rmsnorm(const float* srcf, const bf16_t* srcb, const float* gamma, bf16_t* H, bf16_t* cpy, float* outn) {
    int tid = threadIdx.x; OPQV(tid); const int lane = tid & 63, wave = tid >> 6;
    for (int rq = blockIdx.x * 8 + wave; rq < T_ / 4; rq += gridDim.x * 8) rmsnorm_rows<4>(srcf, srcb, gamma, H, cpy, outn, rq * 4, lane);
}
DEV void phase_rowpass(const bf16_t* P, const float* conv_a, const float* lng, const float* lnb, bf16_t* OA, bf16_t* VN, const float* GLA, const float* GFA) {
    int tid = threadIdx.x; OPQV(tid); const int lane = tid & 63, wave = tid >> 6;
    for (int idx = blockIdx.x * 512 + tid; idx < 64 * 2 * 256; idx += gridDim.x * 512) {
        const int pm = idx >> 9, r = idx & 511, t = r >> 8, c = (r & 255) * 4;
        const bool first = (pm & 7) == 0;
        const float* gf = GFA + ((size_t)(pm * 2 + t) * 2) * 1024 + c;
        const float* gl = GLA + (size_t)(first ? 0 : pm - 1) * 2 * 1024 + c;
        const f32x4 gb = *(const f32x4*)gf, x0 = *(const f32x4*)(gf + 1024);
        f32x4 xm1 = t == 0 ? *(const f32x4*)(gl + 1024) : *(const f32x4*)(GFA + ((size_t)(pm * 2) * 2) * 1024 + 1024 + c);
        f32x4 xm2 = t == 0 ? *(const f32x4*)gl : *(const f32x4*)(gl + 1024);
        if (first) { xm2 = (f32x4){0.f, 0.f, 0.f, 0.f}; if (t == 0) xm1 = xm2; }
        const f32x4 w0 = *(const f32x4*)(conv_a + c), w1 = *(const f32x4*)(conv_a + 1024 + c), w2 = *(const f32x4*)(conv_a + 2048 + c);
        const f32x4 y = gb * (w0 * xm2 + w1 * xm1 + w2 * x0);
        u32x2 o; o.x = cvt_pk_bf16(y[0], y[1]); o.y = cvt_pk_bf16(y[2], y[3]);
        *(u32x2*)(OA + ((size_t)pm * 256 + t) * 1024 + c) = o;
    }
    f32x4 g0[2], g1[2], b0[2], b1[2];
#pragma unroll
    for (int hlf = 0; hlf < 2; ++hlf) { const int c = hlf * 512 + lane * 8; g0[hlf] = *(const f32x4*)(lng + c); g1[hlf] = *(const f32x4*)(lng + c + 4); b0[hlf] = *(const f32x4*)(lnb + c); b1[hlf] = *(const f32x4*)(lnb + c + 4); }
    for (int rp = blockIdx.x * 8 + wave; rp < T_ / 2; rp += gridDim.x * 8) {
        const int row = rp * 2;
        const bf16_t* pr = P + (size_t)row * NP;
        u32x4 vr[2][2];
#pragma unroll
        for (int r = 0; r < 2; ++r)
#pragma unroll
            for (int hlf = 0; hlf < 2; ++hlf) vr[r][hlf] = *(const u32x4*)(pr + (size_t)r * NP + COL_V + hlf * 512 + lane * 8);
#pragma unroll
        for (int r = 0; r < 2; ++r) {
            float v[2][8]; float sm = 0.f;
#pragma unroll
            for (int hlf = 0; hlf < 2; ++hlf) { unpack8(vr[r][hlf], v[hlf]);
#pragma unroll
                for (int j = 0; j < 8; ++j) sm += v[hlf][j]; }
            const float mu = wave_sum(sm) * (1.f / 1024.f);
            float q = 0.f;
#pragma unroll
            for (int hlf = 0; hlf < 2; ++hlf)
#pragma unroll
                for (int j = 0; j < 8; ++j) { const float d = v[hlf][j] - mu; q += d * d; }
            const float rstd = rsqrtf(wave_sum(q) * (1.f / 1024.f) + EPS_);
#pragma unroll
            for (int hlf = 0; hlf < 2; ++hlf) { const int c = hlf * 512 + lane * 8; float o[8];
#pragma unroll
                for (int j = 0; j < 4; ++j) { o[j] = (v[hlf][j] - mu) * rstd * g0[hlf][j] + b0[hlf][j]; o[4 + j] = (v[hlf][4 + j] - mu) * rstd * g1[hlf][j] + b1[hlf][j]; }
                *(u32x4*)(VN + (size_t)(row + r) * 1024 + c) = pack8(o); }
        }
    }
}
DEV void phase_compress(LAS unsigned char* lds, const bf16_t* KV, const float* pos  , const bf16_t* W1T, const bf16_t* W2T, bf16_t* KC, bf16_t* VC) {
    int tid = threadIdx.x; OPQV(tid); const int lane = tid & 63, wv = tid >> 6, fr = lane & 15, g4 = lane >> 4;
    constexpr int PP = 132, HIDO = 4 * 32 * PP * 4;
    LAS float* PART = (LAS float*)lds;
    LAS bf16_t* HID = (LAS bf16_t*)(lds + HIDO);
    for (int item = blockIdx.x; item < 256; item += gridDim.x) {
        const int w = item >> 7, b = (item >> 4) & 7, g = (item >> 2) & 3, qr = item & 3;
        const int kq = wv >> 1, nh = wv & 1;
        const float* posw = pos + w * 2048;
        const bf16_t* w1 = W1T + (size_t)w * 128 * 2048 + (size_t)(nh * 64 + fr) * 2048 + g4 * 8;
        f32x4 acc[2][4];
#pragma unroll
        for (int mt = 0; mt < 2; ++mt)
#pragma unroll
            for (int nt = 0; nt < 4; ++nt) acc[mt][nt] = (f32x4){0.f, 0.f, 0.f, 0.f};
        const int n0 = qr * 32 + fr, n1 = n0 + 16;
        const bool ok0 = n0 < 127, ok1 = n1 < 127;
        const bf16_t* x0 = KV + (size_t)w * KV_TENSOR + ((size_t)(b * 4 + g) * S_ + 16 * min(n0, 126)) * 64 + g4 * 8;
        const bf16_t* x1 = KV + (size_t)w * KV_TENSOR + ((size_t)(b * 4 + g) * S_ + 16 * min(n1, 126)) * 64 + g4 * 8;
#pragma unroll 4
        for (int ks = 0; ks < 16; ++ks) { const int kk = kq * 16 + ks, i = kk >> 1, db = (kk & 1) * 32;
            const f32x4 p0 = *(const f32x4*)(posw + i * 64 + db + g4 * 8), p1 = *(const f32x4*)(posw + i * 64 + db + g4 * 8 + 4);
            const u32x4 xa = *(const u32x4*)(x0 + i * 64 + db);
            const u32x4 xb = *(const u32x4*)(x1 + i * 64 + db);
            bf16x8 bfr[4];
#pragma unroll
            for (int nt = 0; nt < 4; ++nt) bfr[nt] = *(const bf16x8*)(w1 + (size_t)nt * 16 * 2048 + kk * 32);
            float a[8];
            unpack8(xa, a);
#pragma unroll
            for (int j = 0; j < 4; ++j) { a[j] += p0[j]; a[4 + j] += p1[j]; }
#pragma unroll
            for (int j = 0; j < 8; ++j) a[j] = ok0 ? a[j] : 0.f;
            const bf16x8 af0 = as_bf16x8(pack8(a));
            unpack8(xb, a);
#pragma unroll
            for (int j = 0; j < 4; ++j) { a[j] += p0[j]; a[4 + j] += p1[j]; }
#pragma unroll
            for (int j = 0; j < 8; ++j) a[j] = ok1 ? a[j] : 0.f;
            const bf16x8 af1 = as_bf16x8(pack8(a));
#pragma unroll
            for (int nt = 0; nt < 4; ++nt) { acc[0][nt] = __builtin_amdgcn_mfma_f32_16x16x32_bf16(af0, bfr[nt], acc[0][nt], 0, 0, 0);
                acc[1][nt] = __builtin_amdgcn_mfma_f32_16x16x32_bf16(af1, bfr[nt], acc[1][nt], 0, 0, 0); }
        }
#pragma unroll
        for (int mt = 0; mt < 2; ++mt)
#pragma unroll
            for (int nt = 0; nt < 4; ++nt)
#pragma unroll
                for (int r = 0; r < 4; ++r) PART[(kq * 32 + mt * 16 + g4 * 4 + r) * PP + nh * 64 + nt * 16 + fr] = acc[mt][nt][r];
        __syncthreads();
        { const int row = tid >> 4, c8 = (tid & 15) * 8; float hv[8];
#pragma unroll
            for (int j = 0; j < 8; ++j) hv[j] = 0.f;
#pragma unroll
            for (int q = 0; q < 4; ++q) { const f32x4 u0 = *(const LAS f32x4*)(lds + ((q * 32 + row) * PP + c8) * 4), u1 = *(const LAS f32x4*)(lds + ((q * 32 + row) * PP + c8 + 4) * 4);
#pragma unroll
                for (int j = 0; j < 4; ++j) { hv[j] += u0[j]; hv[4 + j] += u1[j]; } }
#pragma unroll
            for (int j = 0; j < 8; ++j) hv[j] = gelu_t(hv[j]);
            *(LAS u32x4*)(lds + HIDO + (row * 136 + c8) * 2) = pack8(hv); }
        __syncthreads();
        { const int mt = wv >> 2, dt = wv & 3;
            const bf16_t* w2 = W2T + (size_t)w * 64 * 128 + (size_t)(dt * 16 + fr) * 128;
            f32x4 o = (f32x4){0.f, 0.f, 0.f, 0.f};
#pragma unroll
            for (int ks = 0; ks < 4; ++ks) { const bf16x8 af = *(const LAS bf16x8*)(lds + HIDO + ((mt * 16 + fr) * 136 + ks * 32 + g4 * 8) * 2);
                const bf16x8 bfr = *(const bf16x8*)(w2 + ks * 32 + g4 * 8);
                o = __builtin_amdgcn_mfma_f32_16x16x32_bf16(af, bfr, o, 0, 0, 0); }
            bf16_t* dst = (w ? VC : KC) + (size_t)(b * 4 + g) * 128 * 64;
#pragma unroll
            for (int r = 0; r < 4; ++r) { const int n = qr * 32 + mt * 16 + g4 * 4 + r; const float ov = n < 127 ? o[r] : 0.f;
                dst[n * 64 + dt * 16 + fr] = (bf16_t)(cvt_pk_bf16(ov, 0.f) & 0xffffu); } }
        __syncthreads();
    }
}
DEV void sgu_item(LAS unsigned char* lds, const bf16_t* P, const bf16_t* VN, const float* sgu_w, const float* sgu_b, bf16_t* OC, int item) {
    int tid = threadIdx.x; OPQV(tid); const int lane = tid & 63, wv = tid >> 6, fr = lane & 15, g4 = lane >> 4;
    LAS bf16_t* VT = (LAS bf16_t*)lds;
    const int g = item & 7, ch = (item >> 3) & 15, b = item >> 7;
    const size_t tok0 = (size_t)b * S_ + ch * 128;
    const int t = wv * 16 + fr;
    const size_t tok = tok0 + t;
    u32x4 vin[4];
#pragma unroll
    for (int it = 0; it < 4; ++it) { const int idx = it * 512 + tid, s = idx >> 4, c8 = (idx & 15) * 8; vin[it] = *(const u32x4*)(VN + (tok0 + s) * 1024 + g * 128 + c8); }
    const float* wrow = sgu_w + ((size_t)g * 128 + t) * 128;
    f32x4 wa[4], wb[4];
#pragma unroll
    for (int ks = 0; ks < 4; ++ks) { wa[ks] = *(const f32x4*)(wrow + ks * 32 + g4 * 8); wb[ks] = *(const f32x4*)(wrow + ks * 32 + g4 * 8 + 4); }
    u32x2 uu[8];
#pragma unroll
    for (int n = 0; n < 8; ++n) uu[n] = *(const u32x2*)(P + tok * NP + COL_U + g * 128 + n * 16 + g4 * 4);
    const float bias = sgu_b[g * 128 + t];
#pragma unroll
    for (int it = 0; it < 4; ++it) { const int idx = it * 512 + tid, s = idx >> 4, c8 = (idx & 15) * 8;
#pragma unroll
        for (int j = 0; j < 4; ++j) { VT[(c8 + 2 * j) * 136 + s] = (bf16_t)(vin[it][j] & 0xffffu); VT[(c8 + 2 * j + 1) * 136 + s] = (bf16_t)(vin[it][j] >> 16); } }
    __syncthreads();
    f32x4 acc[8];
#pragma unroll
    for (int n = 0; n < 8; ++n) acc[n] = (f32x4){0.f, 0.f, 0.f, 0.f};
#pragma unroll
    for (int ks = 0; ks < 4; ++ks) { const int s0 = ks * 32 + g4 * 8;
        float wf[8] = {wa[ks][0], wa[ks][1], wa[ks][2], wa[ks][3], wb[ks][0], wb[ks][1], wb[ks][2], wb[ks][3]};
#pragma unroll
        for (int j = 0; j < 8; ++j) if (s0 + j > t) wf[j] = 0.f;
        const bf16x8 wfr = as_bf16x8(pack8(wf));
#pragma unroll
        for (int n = 0; n < 8; ++n) { const bf16x8 vf = *(const LAS bf16x8*)(lds + ((n * 16 + fr) * 136 + s0) * 2);
            acc[n] = __builtin_amdgcn_mfma_f32_16x16x32_bf16(vf, wfr, acc[n], 0, 0, 0); } }
#pragma unroll
    for (int n = 0; n < 8; ++n) { const int c = g * 128 + n * 16 + g4 * 4;
        u32x2 w; w.x = cvt_pk_bf16(bflo(uu[n].x) * (acc[n][0] + bias), bfhi(uu[n].x) * (acc[n][1] + bias)); w.y = cvt_pk_bf16(bflo(uu[n].y) * (acc[n][2] + bias), bfhi(uu[n].y) * (acc[n][3] + bias));
        *(u32x2*)(OC + tok * 1024 + c) = w; }
    __syncthreads();
}
DEV void phase_actfix(const float* GL, const float* GF, const float* cw, bf16_t* ACT, int pm0, int npm) {
    int tid = threadIdx.x; OPQV(tid);
    for (int idx = tid; idx < npm * 768; idx += 512) {
        const int pm = pm0 + idx / 768, r = idx % 768, t = r / 384, c = (r - t * 384) * 8;
        const bool first = (pm & 7) == 0;
        const float* gf = GF + ((size_t)(pm * 2 + t) * 2) * DFF + c;
        const float* gl = GL + (size_t)(first ? 0 : pm - 1) * 2 * DFF + c;
        const float* gm1p = t == 0 ? gl + DFF : GF + ((size_t)(pm * 2) * 2) * DFF + c;
        const float* gm2p = t == 0 ? gl : gl + DFF;
        float y[8];
#pragma unroll
        for (int hf = 0; hf < 2; ++hf) { const f32x4 g0 = *(const f32x4*)(gf + hf * 4), vv = *(const f32x4*)(gf + DFF + hf * 4);
            f32x4 gm1 = *(const f32x4*)(gm1p + hf * 4), gm2 = *(const f32x4*)(gm2p + hf * 4);
            if (first) { gm2 = (f32x4){0.f, 0.f, 0.f, 0.f}; if (t == 0) gm1 = gm2; }
            const f32x4 w0 = *(const f32x4*)(cw + c + hf * 4), w1 = *(const f32x4*)(cw + DFF + c + hf * 4), w2 = *(const f32x4*)(cw + 2 * DFF + c + hf * 4);
#pragma unroll
            for (int j = 0; j < 4; ++j) y[hf * 4 + j] = gelu_t(w0[j] * gm2[j] + w1[j] * gm1[j] + w2[j] * g0[j]) * vv[j]; }
        *(u32x4*)(ACT + ((size_t)pm * 256 + t) * DFF + c) = pack8(y);
    }
}

constexpr int AT_KS = 0, AT_VT = 18432, AT_BT = 36864, AT_BK = 38944, AT_IMP = 39936, AT_MASK = 72704, AT_IMPF = 72960, AT_RB = 81152, AT_NEXT = 83200;

struct KVRegs { u32x4 k, v; };
DEV KVRegs kv_fetch(const bf16_t* kbase, const bf16_t* vbase, int tid) {
    KVRegs r;
    r.k = *(const u32x4*)(kbase + tid * 8); r.v = *(const u32x4*)(vbase + (tid & 63) * 64 + (tid >> 6) * 8); return r;
}
DEV void kv_store(LAS unsigned char* lds, const KVRegs& r, int buf, int tid) {
    const int key = tid >> 3, c8 = (tid & 7) * 8;
    unsigned kw = AT_KS + buf * 9216 + (key * 72 + c8) * 2, vw = AT_VT + buf * 9216 + ((tid >> 6) * 8 * 72 + (tid & 63)) * 2; OPQV(kw); OPQV(vw);
    *(LAS u32x4*)(lds + kw) = r.k;
#pragma unroll
    for (int j = 0; j < 4; ++j) { *(LAS bf16_t*)(lds + vw + j * 288) = (bf16_t)(r.v[j] & 0xffffu); *(LAS bf16_t*)(lds + vw + j * 288 + 144) = (bf16_t)(r.v[j] >> 16); }
}

DEV void attn_tile(LAS unsigned char* lds, const bf16x8 (&qf)[2][2], int tl, int kpos0, int mode, bool near, bool rowsel, const float (&cbias)[2],
                   unsigned kb, unsigned vb_, unsigned btb, int g4, float (&mrun)[2], float (&lrun)[2], f32x4 (&O)[2][4]) {
    f32x4 sc[2][4];
    float ci[2];
#pragma unroll
    for (int hh = 0; hh < 2; ++hh) { const float mne = mrun[hh] < -1e29f ? 0.f : mrun[hh];
        ci[hh] = near ? -mne : (((mode == 1 && !rowsel) ? NEG_ : cbias[hh]) - mne); }
    {
        bf16x8 kf[4][2];
#pragma unroll
        for (int kt = 0; kt < 4; ++kt) { kf[kt][0] = *(const LAS bf16x8*)(lds + kb + kt * 2304); kf[kt][1] = *(const LAS bf16x8*)(lds + kb + kt * 2304 + 64); }
        __builtin_amdgcn_sched_barrier(0);
#pragma unroll
        for (int kt = 0; kt < 4; ++kt)
#pragma unroll
            for (int hh = 0; hh < 2; ++hh) sc[hh][kt] = __builtin_amdgcn_mfma_f32_16x16x32_bf16(kf[kt][0], qf[hh][0], (f32x4){ci[hh], ci[hh], ci[hh], ci[hh]}, 0, 0, 0);
#pragma unroll
        for (int kt = 0; kt < 4; ++kt)
#pragma unroll
            for (int hh = 0; hh < 2; ++hh) sc[hh][kt] = __builtin_amdgcn_mfma_f32_16x16x32_bf16(kf[kt][1], qf[hh][1], sc[hh][kt], 0, 0, 0);
    }
    if (near) {
#pragma unroll
        for (int kt = 0; kt < 4; ++kt)
#pragma unroll
            for (int r = 0; r < 4; ++r) { const int dist = tl - (kpos0 + kt * 16 + g4 * 4 + r);
                const bool valid = dist >= 0 && (mode == 1 ? rowsel : dist < 512);
                const int idx = dist < 0 ? 0 : (dist > 128 ? 128 : dist);
#pragma unroll
                for (int hh = 0; hh < 2; ++hh) { const float s = sc[hh][kt][r] + *(const LAS float*)(lds + btb + idx * 4 + hh * 516); sc[hh][kt][r] = valid ? s : NEG_; } }
    }
    bf16x8 pf[2][2];
#pragma unroll
    for (int hh = 0; hh < 2; ++hh) {
        float lm = fmaxf(fmaxf(sc[hh][0][0], sc[hh][0][1]), fmaxf(sc[hh][0][2], sc[hh][0][3]));
#pragma unroll
        for (int kt = 1; kt < 4; ++kt) lm = fmaxf(lm, fmaxf(fmaxf(sc[hh][kt][0], sc[hh][kt][1]), fmaxf(sc[hh][kt][2], sc[hh][kt][3])));
        const bool inval = mrun[hh] < -1e29f;
        if (__any(lm > (inval ? -1e29f : 20.f))) {
            float mx = fmaxf(lm, __shfl_xor(lm, 16)); mx = fmaxf(mx, __shfl_xor(mx, 32));
            float d = 0.f, alpha = 1.f;
            if (mx > -1e29f) { d = inval ? mx : fmaxf(mx, 0.f); alpha = inval ? 1.f : __builtin_amdgcn_exp2f(-d); mrun[hh] = inval ? mx : mrun[hh] + d; }
#pragma unroll
            for (int kt = 0; kt < 4; ++kt) sc[hh][kt] = sc[hh][kt] - d;
            lrun[hh] *= alpha;
#pragma unroll
            for (int dt = 0; dt < 4; ++dt) O[hh][dt] = O[hh][dt] * alpha;
        }
        float rs = 0.f;
#pragma unroll
        for (int kt = 0; kt < 4; ++kt)
#pragma unroll
            for (int r = 0; r < 4; ++r) { const float p = __builtin_amdgcn_exp2f(sc[hh][kt][r]); sc[hh][kt][r] = p; rs += p; }
        lrun[hh] += rs;
#pragma unroll
        for (int kc = 0; kc < 2; ++kc) { u32x4 w; w.x = cvt_pk_bf16(sc[hh][2 * kc][0], sc[hh][2 * kc][1]); w.y = cvt_pk_bf16(sc[hh][2 * kc][2], sc[hh][2 * kc][3]);
            w.z = cvt_pk_bf16(sc[hh][2 * kc + 1][0], sc[hh][2 * kc + 1][1]); w.w = cvt_pk_bf16(sc[hh][2 * kc + 1][2], sc[hh][2 * kc + 1][3]); pf[hh][kc] = as_bf16x8(w); }
    }
#pragma unroll
    for (int dt = 0; dt < 4; ++dt)
#pragma unroll
        for (int kc = 0; kc < 2; ++kc) {
            const u32x2 va = *(const LAS u32x2*)(lds + vb_ + dt * 2304 + kc * 64);
            const u32x2 vb = *(const LAS u32x2*)(lds + vb_ + dt * 2304 + kc * 64 + 32);
            const bf16x8 vf = as_bf16x8((u32x4){va.x, va.y, vb.x, vb.y});
#pragma unroll
            for (int hh = 0; hh < 2; ++hh) O[hh][dt] = __builtin_amdgcn_mfma_f32_16x16x32_bf16(vf, pf[hh][kc], O[hh][dt], 0, 0, 0);
        }
}

DEV void attn_item(LAS unsigned char* lds, const bf16_t* P, const bf16_t* QB, const bf16_t* KV, const bf16_t* KC, const bf16_t* VC, const float* rel_bias, bf16_t* OB, int b, int g, int qt) {
    int tid = threadIdx.x; OPQV(tid);
    const int lane = tid & 63, wave = tid >> 6, fr = lane & 15, g4 = lane >> 4;
    const int qs = wave >> 1, hp = wave & 1;
    const int tl = qt * 64 + qs * 16 + fr;
    const size_t tok = (size_t)b * S_ + tl;
    unsigned kb = AT_KS + (fr * 72 + g4 * 8) * 2, vb1 = AT_VT + (fr * 72 + g4 * 4) * 2, vb2 = AT_VT + (fr * 136 + g4 * 4) * 2, btb = AT_BT + hp * 1032;
    OPQV(kb); OPQV(vb1); OPQV(vb2); OPQV(btb);
    LAS float* BT = (LAS float*)(lds + AT_BT);
    const LAS int* BK = (const LAS int*)(lds + AT_BK);
    LAS float* IA = (LAS float*)(lds + AT_IMP);
    LAS float* IB = (LAS float*)(lds + AT_IMP + 16384);
    LAS unsigned* MASK = (LAS unsigned*)(lds + AT_MASK);

    bf16x8 qf[2][2];
#pragma unroll
    for (int hh = 0; hh < 2; ++hh)
#pragma unroll
        for (int ks = 0; ks < 2; ++ks) { float qv[8]; unpack8(*(const u32x4*)(QB + tok * 1024 + (g * 4 + hp * 2 + hh) * 64 + ks * 32 + g4 * 8), qv);
#pragma unroll
            for (int e = 0; e < 8; ++e) qv[e] *= QSC_;
            qf[hh][ks] = as_bf16x8(pack8(qv)); }
    float gate[3][2];
#pragma unroll
    for (int br = 0; br < 3; ++br)
#pragma unroll
        for (int hh = 0; hh < 2; ++hh) gate[br][hh] = bf2f(P[tok * NP + COL_GN + br * 16 + g * 4 + hp * 2 + hh]);
    f32x4 F[2][4];
#pragma unroll
    for (int hh = 0; hh < 2; ++hh)
#pragma unroll
        for (int dt = 0; dt < 4; ++dt) F[hh][dt] = (f32x4){0.f, 0.f, 0.f, 0.f};

    const bf16_t* pbg = KV + (size_t)(b * 4 + g) * S_ * 64;
    KVRegs pre = kv_fetch(pbg + 2 * KV_TENSOR, pbg + 3 * KV_TENSOR, tid);
    {
        const bf16_t* kc = KC + (size_t)(b * 4 + g) * 128 * 64; const bf16_t* vc = VC + (size_t)(b * 4 + g) * 128 * 64;
#pragma unroll
        for (int it = 0; it < 2; ++it) { const int idx = it * 512 + tid, key = idx >> 3, c8 = (idx & 7) * 8;
            const u32x4 kv = *(const u32x4*)(kc + key * 64 + c8); const u32x4 vv = *(const u32x4*)(vc + key * 64 + c8);
            unsigned kw = AT_KS + (key * 72 + c8) * 2, vw = AT_VT + (c8 * 136 + key) * 2; OPQV(kw); OPQV(vw);
            *(LAS u32x4*)(lds + kw) = kv;
#pragma unroll
            for (int j = 0; j < 4; ++j) { *(LAS bf16_t*)(lds + vw + j * 544) = (bf16_t)(vv[j] & 0xffffu); *(LAS bf16_t*)(lds + vw + j * 544 + 272) = (bf16_t)(vv[j] >> 16); } }
        for (int e = tid; e < 4 * 129; e += 512) { const int r = e / 129, idx = e - r * 129; BT[e] = LOG2E_ * *(const LAS float*)(lds + AT_RB + (BK[idx] * 16 + g * 4 + r) * 4); }
    }
    __syncthreads();
    {
        const int nkt = min(8, (4 * qt + 2) / 16 + 1);
        float ia[8], ib[8];
#pragma unroll
        for (int kt = 0; kt < 8; ++kt) { ia[kt] = 0.f; ib[kt] = 0.f; }
#pragma unroll
        for (int hh = 0; hh < 2; ++hh) {
            f32x4 sc[8];
#pragma unroll
            for (int kt = 0; kt < 8; ++kt) {
                if (kt < nkt) {
                    const bf16x8 k0 = *(const LAS bf16x8*)(lds + kb + kt * 2304);
                    const bf16x8 k1 = *(const LAS bf16x8*)(lds + kb + kt * 2304 + 64);
                    f32x4 a = (f32x4){0.f, 0.f, 0.f, 0.f};
                    a = __builtin_amdgcn_mfma_f32_16x16x32_bf16(k0, qf[hh][0], a, 0, 0, 0);
                    a = __builtin_amdgcn_mfma_f32_16x16x32_bf16(k1, qf[hh][1], a, 0, 0, 0);
#pragma unroll
                    for (int r = 0; r < 4; ++r) { const int n = kt * 16 + g4 * 4 + r; const int dist = tl - (16 * n + 31);
                        const int idx = dist < 0 ? 0 : (dist > 128 ? 128 : dist);
                        const float s = a[r] + *(const LAS float*)(lds + btb + idx * 4 + hh * 516);
                        a[r] = dist >= 0 ? s : NEG_; }
                    sc[kt] = a;
                } else sc[kt] = (f32x4){NEG_, NEG_, NEG_, NEG_};
            }
            float mx = NEG_;
#pragma unroll
            for (int kt = 0; kt < 8; ++kt)
#pragma unroll
                for (int r = 0; r < 4; ++r) mx = fmaxf(mx, sc[kt][r]);
            mx = fmaxf(mx, __shfl_xor(mx, 16)); mx = fmaxf(mx, __shfl_xor(mx, 32));
            float rs = 0.f;
#pragma unroll
            for (int kt = 0; kt < 8; ++kt)
#pragma unroll
                for (int r = 0; r < 4; ++r) { const float s = sc[kt][r]; const float p = s > -1e29f ? __builtin_amdgcn_exp2f(s - mx) : 0.f; sc[kt][r] = p; rs += p; }
            rs += __shfl_xor(rs, 16); rs += __shfl_xor(rs, 32);
            const float inv = rs > 0.f ? 1.f / rs : 0.f;
#pragma unroll
            for (int kt = 0; kt < 8; ++kt) { sc[kt] = sc[kt] * inv; ia[kt] += (sc[kt][0] + sc[kt][1]) + (sc[kt][2] + sc[kt][3]); ib[kt] += sc[kt][3]; }
            f32x4 Oc[4];
#pragma unroll
            for (int dt = 0; dt < 4; ++dt) Oc[dt] = (f32x4){0.f, 0.f, 0.f, 0.f};
#pragma unroll
            for (int kc = 0; kc < 4; ++kc) {
                if (2 * kc < nkt) {
                    u32x4 w; w.x = cvt_pk_bf16(sc[2 * kc][0], sc[2 * kc][1]); w.y = cvt_pk_bf16(sc[2 * kc][2], sc[2 * kc][3]);
                    w.z = cvt_pk_bf16(sc[2 * kc + 1][0], sc[2 * kc + 1][1]); w.w = cvt_pk_bf16(sc[2 * kc + 1][2], sc[2 * kc + 1][3]);
                    const bf16x8 pf = as_bf16x8(w);
#pragma unroll
                    for (int dt = 0; dt < 4; ++dt) {
                        const u32x2 va = *(const LAS u32x2*)(lds + vb2 + dt * 4352 + kc * 64);
                        const u32x2 vb = *(const LAS u32x2*)(lds + vb2 + dt * 4352 + kc * 64 + 32);
                        const bf16x8 vf = as_bf16x8((u32x4){va.x, va.y, vb.x, vb.y});
                        Oc[dt] = __builtin_amdgcn_mfma_f32_16x16x32_bf16(vf, pf, Oc[dt], 0, 0, 0);
                    }
                }
            }
#pragma unroll
            for (int dt = 0; dt < 4; ++dt) F[hh][dt] = F[hh][dt] + Oc[dt] * gate[0][hh];
            __builtin_amdgcn_sched_barrier(0);
        }
        unsigned iw = AT_IMP + ((hp * 64 + qs * 16 + fr) * 32 + g4) * 4; OPQV(iw);
#pragma unroll
        for (int kt = 0; kt < 8; ++kt) { *(LAS float*)(lds + iw + kt * 16) = ia[kt]; *(LAS float*)(lds + iw + kt * 16 + 16384) = ib[kt]; }
    }
    __syncthreads();
    {
        LAS float* IMPF = (LAS float*)(lds + AT_IMPF);
#pragma unroll
        for (int it = 0; it < 4; ++it) { const int e = it * 512 + tid, q = e >> 5, j = e & 31;
            float v = IA[q * 32 + j] + IA[(64 + q) * 32 + j]; if (j > 0) v += IB[q * 32 + j - 1] + IB[(64 + q) * 32 + j - 1];
            IMPF[e] = v; }
        __syncthreads();
        const int cur = qt;
        const unsigned forced = 1u | (1u << cur) | (cur > 0 ? (1u << (cur - 1)) : 0u);
        const int need = 8 - __popc(forced);
        for (int it = 0; it < 4; ++it) { const int q = wave * 8 + it * 2 + (lane >> 5), j = lane & 31;
            const float v = IMPF[q * 32 + j]; int rank = 0;
            for (int jp = 1; jp <= cur - 2; ++jp) { const float vp = IMPF[q * 32 + jp]; rank += (vp > v || (vp == v && jp < j)) ? 1 : 0; }
            const bool sel = (j >= 1) && (j <= cur - 2) && (rank < need);
            const unsigned long long bal = __ballot(sel);
            const unsigned mq = forced | (unsigned)(lane < 32 ? bal : (bal >> 32));
            if (j == 0) MASK[q] = mq; }
    }
    __syncthreads();
    const unsigned mymask = MASK[qs * 16 + fr];
    unsigned anym = MASK[lane];
#pragma unroll
    for (int o = 32; o >= 1; o >>= 1) anym |= __shfl_xor(anym, o);
    anym = __builtin_amdgcn_readfirstlane(anym);
    {
        float cbias[2]; cbias[0] = *(const LAS float*)(lds + btb + 512); cbias[1] = *(const LAS float*)(lds + btb + 512 + 516);
        float mrun[2] = {NEG_, NEG_}, lrun[2] = {0.f, 0.f}; f32x4 O[2][4];
#pragma unroll
        for (int hh = 0; hh < 2; ++hh)
#pragma unroll
            for (int dt = 0; dt < 4; ++dt) O[hh][dt] = (f32x4){0.f, 0.f, 0.f, 0.f};
        unsigned rem = anym & (qt >= 31 ? 0xffffffffu : ((2u << qt) - 1u)); rem &= ~1u;
        int mode = 1, j = 0, buf = 0;
        for (;;) {
            kv_store(lds, pre, buf, tid);
            __syncthreads();
            int mode_n = mode, j_n = 0; bool more = true;
            if (mode == 1) { if (rem != 0u) { j_n = __builtin_ctz(rem); rem &= rem - 1u; } else { mode_n = 2; j_n = max(0, qt - 8); } }
            else { j_n = j + 1; more = j_n <= qt; }
            if (more) { const bf16_t* base = pbg + (size_t)j_n * 64 * 64 + (mode_n == 1 ? 2 : 4) * KV_TENSOR; pre = kv_fetch(base, base + KV_TENSOR, tid); }
            const bool near = (j >= qt - 2) || (mode == 2 && j == qt - 8);
            attn_tile(lds, qf, tl, j * 64, mode, near, ((mymask >> j) & 1u) != 0u, cbias, kb + buf * 9216, vb1 + buf * 9216, btb, g4, mrun, lrun, O);
            if (mode_n != mode || !more) {
#pragma unroll
                for (int hh = 0; hh < 2; ++hh) { float lt = lrun[hh]; lt += __shfl_xor(lt, 16); lt += __shfl_xor(lt, 32); const float sc = lt > 0.f ? gate[mode][hh] / lt : 0.f;
#pragma unroll
                    for (int dt = 0; dt < 4; ++dt) { F[hh][dt] = F[hh][dt] + O[hh][dt] * sc; O[hh][dt] = (f32x4){0.f, 0.f, 0.f, 0.f}; }
                    mrun[hh] = NEG_; lrun[hh] = 0.f; }
            }
            if (!more) break;
            mode = mode_n; j = j_n; buf ^= 1;
        }
    }
#pragma unroll
    for (int hh = 0; hh < 2; ++hh)
#pragma unroll
        for (int dt = 0; dt < 4; ++dt) { u32x2 w; w.x = cvt_pk_bf16(F[hh][dt][0], F[hh][dt][1]); w.y = cvt_pk_bf16(F[hh][dt][2], F[hh][dt][3]);
            *(u32x2*)(OB + tok * 1024 + (g * 4 + hp * 2 + hh) * 64 + dt * 16 + g4 * 4) = w; }
}

DEV void phase_mix(LAS unsigned char* lds, const bf16_t* P, const bf16_t* QB, const bf16_t* KV, const bf16_t* KC, const bf16_t* VC, const float* rel_bias, bf16_t* OB,
                   const bf16_t* VN, const float* sgu_w, const float* sgu_b, bf16_t* OC, int* ctr) {
    int tid = threadIdx.x; OPQV(tid);
    LAS int* BK = (LAS int*)(lds + AT_BK);
    if (tid < 129) { int bk; if (tid < 16) bk = tid; else { const float lr = log2f((float)tid * (1.f / 16.f)) * (1.f / 3.f); bk = 16 + (int)(lr * 16.f); if (bk > 31) bk = 31; } BK[tid] = bk; }
    *(LAS float*)(lds + AT_RB + tid * 4) = rel_bias[tid];
    __syncthreads();
    for (;;) {
        if (tid == 0) *(LAS int*)(lds + AT_NEXT) = atomicAdd(ctr, 1);
        __syncthreads();
        const int i = *(const LAS int*)(lds + AT_NEXT);
        __syncthreads();
        if (i >= 2048) break;
        if (i < 1024) attn_item(lds, P, QB, KV, KC, VC, rel_bias, OB, (i & 31) >> 2, i & 3, 31 - (i >> 5));
        else sgu_item(lds, P, VN, sgu_w, sgu_b, OC, i - 1024);
        __syncthreads();
    }
}


#define XB_TMO      128
#define XB_XCNT(j)  (256  + 64 * (j))
#define XB_XSUB(j)  (1280 + 64 * (j))
#define XB_XGEN(j)  (2304 + 64 * (j))
#define XB_TOP      3328
#define XB_TOPGEN   3392
#define XCD_BAR_WORDS 3456
#define XB_SPIN_CAP (1u << 20)
DEV unsigned xb_ld(unsigned* p)              { return __hip_atomic_load(p, __ATOMIC_RELAXED, __HIP_MEMORY_SCOPE_AGENT); }
DEV unsigned xb_add(unsigned* p, unsigned v) { return __hip_atomic_fetch_add(p, v, __ATOMIC_RELAXED, __HIP_MEMORY_SCOPE_AGENT); }
DEV unsigned xb_xcc_id() { return (unsigned)__builtin_amdgcn_s_getreg((3 << 11) | 20) & 0xFu; }
#define XB_SPIN(cond, bar) do { unsigned _sp = 0; while (cond) { __builtin_amdgcn_s_sleep(1); \
    if ((++_sp & 255u) == 0u) { if (xb_ld(&(bar)[XB_TMO])) break; if (_sp > XB_SPIN_CAP) { atomicAdd(&(bar)[XB_TMO], 1u); break; } } } } while (0)
struct XcdBarrier { unsigned* bar; unsigned x; volatile LAS unsigned* st; };
DEV XcdBarrier xcd_barrier_post(unsigned* bar, volatile LAS unsigned* st) {
    XcdBarrier b; b.bar = bar; b.x = xb_xcc_id(); b.st = st;
    if (threadIdx.x == 0) (void)xb_add(&bar[XB_XCNT(b.x)], 1u);
    return b;
}
DEV void xcd_barrier_complete(unsigned* bar, unsigned x, unsigned& nloc, unsigned& nx) {
    const unsigned G = gridDim.x * gridDim.y * gridDim.z;
    unsigned sum, cnt, mine, sp = 0u;
    for (;;) {
        sum = 0u; cnt = 0u; mine = 0u;
#pragma unroll
        for (unsigned j = 0; j < 16; ++j) { const unsigned c = xb_ld(&bar[XB_XCNT(j)]); sum += c; cnt += (c > 0u) ? 1u : 0u; mine = (j == x) ? c : mine; }
        if (sum == G) break;
        __builtin_amdgcn_s_sleep(1);
        if ((++sp & 255u) == 0u) { if (xb_ld(&bar[XB_TMO])) break; if (sp > XB_SPIN_CAP) { atomicAdd(&bar[XB_TMO], 1u); break; } }
    }
    nloc = mine > 0u ? mine : 1u; nx = cnt > 0u ? cnt : 1u;
}
DEV void xcd_barrier(const XcdBarrier& b) {
    asm volatile("s_waitcnt vmcnt(0)" ::: "memory");
    __syncthreads();
    if (threadIdx.x == 0) {
        unsigned* bar = b.bar;
        __builtin_amdgcn_s_waitcnt(0);
        unsigned nloc = b.st[0], nx = b.st[1];
        if (nloc == 0u) { xcd_barrier_complete(bar, b.x, nloc, nx); b.st[0] = nloc; b.st[1] = nx; }
        const unsigned old = xb_add(&bar[XB_XSUB(b.x)], 1u);
        const unsigned gen = old / nloc;
        if (old + 1u == (gen + 1u) * nloc) {
            __builtin_amdgcn_fence(__ATOMIC_RELEASE, "agent");
            asm volatile("s_waitcnt vmcnt(0)" ::: "memory");
            const unsigned og = xb_add(&bar[XB_TOP], 1u);
            const unsigned tg = og / nx;
            if (og + 1u == (tg + 1u) * nx) xb_add(&bar[XB_TOPGEN], 1u);
            else XB_SPIN(xb_ld(&bar[XB_TOPGEN]) == tg, bar);
            __builtin_amdgcn_fence(__ATOMIC_ACQUIRE, "agent");
            xb_add(&bar[XB_XGEN(b.x)], 1u);
            asm volatile("s_waitcnt vmcnt(0)" ::: "memory");
        } else {
            XB_SPIN(xb_ld(&bar[XB_XGEN(b.x)]) == gen, bar);
            __builtin_amdgcn_fence(__ATOMIC_ACQUIRE, "agent");
            asm volatile("s_waitcnt vmcnt(0)" ::: "memory");
        }
    }
    __syncthreads();
}

typedef const __attribute__((address_space(4))) Params* KParams;
__global__ void __launch_bounds__(512, 2) fwd_mega(Params p_unused) {
    extern __shared__ __attribute__((aligned(16))) unsigned char lds_raw[];
    LAS unsigned char* lds = (LAS unsigned char*)lds_raw;
    { volatile LAS unsigned* st = (volatile LAS unsigned*)(lds + 131072); if (threadIdx.x < 4) st[threadIdx.x] = 0u; }
    __syncthreads();
    KParams kp0 = (KParams)__builtin_amdgcn_kernarg_segment_ptr();
    XcdBarrier xbar = xcd_barrier_post((unsigned*)(kp0->ws + WS_BAR), (volatile LAS unsigned*)(lds + 131072));
    const int ph_lo = kp0->ph_lo, ph_hi = kp0->ph_hi;

    for (int ph = ph_lo; ph < ph_hi; ++ph) {
        KParams kp = (KParams)__builtin_amdgcn_kernarg_segment_ptr(); OPQS(kp);
        struct { KParams k; DEV const float* operator[](int i) const { return k->in[i]; } } pin{kp};
        unsigned char* ws = kp->ws;
        bf16_t* WIN = (bf16_t*)(ws + WS_WIN); bf16_t* WBR = (bf16_t*)(ws + WS_WBR); bf16_t* WO = (bf16_t*)(ws + WS_WO); bf16_t* WUP = (bf16_t*)(ws + WS_WUP);
        bf16_t* WDN = (bf16_t*)(ws + WS_WDN); bf16_t* W1T = (bf16_t*)(ws + WS_W1T); bf16_t* W2T = (bf16_t*)(ws + WS_W2T);
        bf16_t* KC = (bf16_t*)(ws + WS_KC); bf16_t* VC = (bf16_t*)(ws + WS_VC); bf16_t* H = (bf16_t*)(ws + WS_H); bf16_t* P = (bf16_t*)(ws + WS_P);
        bf16_t* O3 = (bf16_t*)(ws + WS_O3);
        bf16_t* OA = O3; bf16_t* OB = O3 + (size_t)T_ * 1024; bf16_t* OC = O3 + (size_t)2 * T_ * 1024;
        bf16_t* X = (bf16_t*)(ws + WS_X); float* OUT = kp->out;
        const int G = gridDim.x, c = blockIdx.x;
        if (ph == NPHASE - 1) {
            if (PHON(10)) phase_rmsnorm(nullptr, X, pin[20], nullptr, nullptr, OUT);
        } else {
            const int l = ph / 10, k = ph % 10;
            if (k == 0) { if (PHON(0)) {
                if (l == 0 && blockIdx.x == 0 && threadIdx.x < 4) ((int*)(ws + WS_MF))[threadIdx.x * 64] = 0;
                convT<128>(lds, pin[3] + (size_t)l * 1024 * NIN, 1024, NIN, WIN, NP, 1, 0);
                convT<128>(lds, pin[12] + (size_t)l * 1024 * 1024, 1024, 1024, WBR, 1024, 0, 192);
                convT<128>(lds, pin[13] + (size_t)l * 1024 * 1024, 1024, 1024, WBR + (size_t)1024 * 1024, 1024, 0, 192);
                convT<128>(lds, pin[14] + (size_t)l * 1024 * 1024, 1024, 1024, WBR + (size_t)2048 * 1024, 1024, 0, 192);
                convT<128>(lds, pin[15] + (size_t)l * 1024 * 1024, 1024, 1024, WO, 1024, 0, 192);
                convT<128>(lds, pin[17] + (size_t)l * 1024 * 6144, 1024, 6144, WUP, 6144, 2, 192);
                convT<128>(lds, pin[19] + (size_t)l * 3072 * 1024, 3072, 1024, WDN, 1024, 0, 192);
                convT<128>(lds, pin[6] + (size_t)(l * 2 + 0) * 2048 * 128, 2048, 128, W1T, 128, 0, 0);
                convT<128>(lds, pin[6] + (size_t)(l * 2 + 1) * 2048 * 128, 2048, 128, W1T + (size_t)128 * 2048, 128, 0, 64);
                convT<64>(lds, pin[7] + (size_t)(l * 2 + 0) * 128 * 64, 128, 64, W2T, 64, 0, 128);
                convT<64>(lds, pin[7] + (size_t)(l * 2 + 1) * 128 * 64, 128, 64, W2T + (size_t)64 * 128, 64, 0, 130);
                phase_rmsnorm(l == 0 ? pin[0] : nullptr, X, pin[2] + l * 1024, H, l == 0 ? X : nullptr, nullptr); }
            } else if (k == 1) { if (PHON(1)) {
                pg8::Gemm g{H, WIN, T_, NP, 1024}; pg8::StaticOrder S; S.init(T_, NP, G, c); pg8::EpiProj E{P, NP, 0, (bf16_t*)(ws + WS_KV), OA, (bf16_t*)(ws + WS_QB), pin[4] + (size_t)l * 3 * 1024, (float*)(ws + WS_GLA), (float*)(ws + WS_GFA), lds + LDS_EX};
                pg8::gemm_phase(lds, g, S, E); }
            } else if (k == 2) { if (PHON(2)) {
                phase_compress(lds, (const bf16_t*)(ws + WS_KV), pin[5] + (size_t)l * 2 * 2048, W1T, W2T, KC, VC);
                phase_rowpass(P, pin[4] + (size_t)l * 3 * 1024, pin[10] + l * 1024, pin[11] + l * 1024, OA, H  , (const float*)(ws + WS_GLA), (const float*)(ws + WS_GFA)); }
            } else if (k == 3) { if (PHON(3)) {
                if (PHON(11)) phase_mix(lds, P, (const bf16_t*)(ws + WS_QB), (const bf16_t*)(ws + WS_KV), KC, VC, pin[1], OB, H  , pin[8] + (size_t)l * 8 * 128 * 128, pin[9] + (size_t)l * 8 * 128, OC, (int*)(ws + WS_MF) + l * 64); }
            } else if (k == 4) { if (PHON(4)) {
                pg8::Gemm g{O3, WBR, 3 * T_, 3072, 1024}; pg8::BranchOrder S; S.init(G, c); pg8::EpiBranch E{P, H  };
                pg8::gemm_phase(lds, g, S, E); }
            } else if (k == 5) { if (PHON(5)) {
                pg8::Gemm g{H  , WO, T_, 1024, 1024}; pg8::StaticOrder S; S.init(T_, 1024, G, c); pg8::EpiRes E{X};
                pg8::gemm_phase(lds, g, S, E); }
            } else if (k == 6) { if (PHON(6)) {
                phase_rmsnorm(nullptr, X, pin[16] + l * 1024, H, nullptr, nullptr); }
            } else if (k == 7) { if (PHON(7)) {
                pg8::Gemm g{H, WUP, T_, 6144, 1024}; pg8::StaticOrder S; S.init(T_, 6144, G, c);
                pg8::EpiAct E{O3  , pin[18] + (size_t)l * 3 * DFF, (float*)(ws + WS_GL), (float*)(ws + WS_GF), lds + LDS_EX};
                pg8::gemm_phase(lds, g, S, E); }
            } else if (k == 8) {
                continue;
            } else { if (PHON(9)) {
                pg8::Gemm g{O3  , WDN, T_, 1024, 3072}; pg8::StaticOrder S; S.init(T_, 1024, G, c); pg8::EpiRes E{X};
                for (int i = 0;; ++i) { pg8::Unit uu; if (!S.next(i, uu)) break;
                    phase_actfix((const float*)(ws + WS_GL), (const float*)(ws + WS_GF), pin[18] + (size_t)l * 3 * DFF, O3  , uu.pm, 1); }
                asm volatile("s_waitcnt vmcnt(0)" ::: "memory"); __syncthreads();
                pg8::gemm_phase(lds, g, S, E); }
            }
        }
        if (ph + 1 < ph_hi) { if (ph == ph_lo) cg::this_grid().sync(); else xcd_barrier(xbar); }
    }
}

extern "C" void kernel_launch(void* const* d_in, const int* in_sizes, int n_in, void* d_out, int out_size, void* d_ws, size_t ws_size, hipStream_t stream) {
    static int grid = 0;
    if (grid == 0) {
        if (n_in != 21 || out_size != T_ * 1024 || ws_size < WS_END) { fprintf(stderr, "kernel_launch: unexpected shapes (n_in %d out %d ws %zu need %zu)\n", n_in, out_size, ws_size, (size_t)WS_END); grid = -1; return; }
        int dev = 0, cus = 0, per_cu = 0;
        hipGetDevice(&dev); hipDeviceGetAttribute(&cus, hipDeviceAttributeMultiprocessorCount, dev);
        hipFuncSetAttribute((const void*)fwd_mega, hipFuncAttributeMaxDynamicSharedMemorySize, LDS_BYTES);
        hipOccupancyMaxActiveBlocksPerMultiprocessor(&per_cu, (const void*)fwd_mega, 512, LDS_BYTES);
        if (per_cu < 1) { fprintf(stderr, "kernel_launch: occupancy query says %d blocks per CU\n", per_cu); per_cu = 1; }
        (void)hipGetLastError();
        grid = cus;
    }
    if (grid < 0) return;
    if (hipMemsetAsync((char*)d_ws + WS_BAR, 0, XCD_BAR_WORDS * 4, stream) != hipSuccess) { fprintf(stderr, "kernel_launch: memset of the barrier words failed\n"); return; }
    Params p{};
    for (int i = 0; i < 21; ++i) p.in[i] = (const float*)d_in[i];
    p.out = (float*)d_out; p.ws = (unsigned char*)d_ws;
#if PER_PHASE_LAUNCH
    for (int ph = 0; ph < NPHASE; ++ph) { p.ph_lo = ph; p.ph_hi = ph + 1; hipLaunchKernelGGL(fwd_mega, dim3(grid), dim3(512), LDS_BYTES, stream, p); }
#else
    p.ph_lo = 0; p.ph_hi = NPHASE;
    void* args[] = {&p};
    hipError_t e = hipLaunchCooperativeKernel((const void*)fwd_mega, dim3(grid), dim3(512), args, LDS_BYTES, stream);
    if (e != hipSuccess) fprintf(stderr, "cooperative launch failed: %s (grid %d)\n", hipGetErrorString(e), grid);
#endif
}
```

```cpp
#include <hip/hip_runtime.h>
#include <hip/hip_cooperative_groups.h>
#include <cstdio>
namespace cg = cooperative_groups;

#ifndef PHASE_MASK
#define PHASE_MASK 0x1fff
#endif
#define PHON(k) ((PHASE_MASK >> (k)) & 1)
#ifndef PER_PHASE_LAUNCH
#define PER_PHASE_LAUNCH 0
#endif

#define LAS __attribute__((address_space(3)))
#define DEV __device__ __forceinline__
#define OPQV(x) asm volatile("" : "+v"(x))
#define OPQS(x) asm volatile("" : "+s"(x))
typedef unsigned short bf16_t;
typedef short bf16x8 __attribute__((ext_vector_type(8)));
typedef float f32x4 __attribute__((ext_vector_type(4)));
typedef unsigned u32x4 __attribute__((ext_vector_type(4)));
typedef unsigned u32x2 __attribute__((ext_vector_type(2)));

constexpr int T_ = 16384, S_ = 2048, NP = 11008, NIN = 10800, DFF = 3072;
constexpr int COL_GB = 0, COL_GC = 1024, COL_VA = 2048, COL_Q = 3072, COL_KC = 4096, COL_VC = 4352, COL_KS = 4608, COL_VS = 4864,
              COL_KW = 5120, COL_VW = 5376, COL_U = 5632, COL_V = 6656, COL_G0 = 7680, COL_GN = 10752;
constexpr float EPS_ = 1e-6f, SCALE_ = 0.125f, NEG_ = -1e30f, LOG2E_ = 1.4426950408889634f, QSC_ = 0.125f * 1.4426950408889634f;
constexpr int LDS_EX = 131072 + 16;
constexpr int LDS_BYTES = 131072 + 16 + 1024;
constexpr int NPHASE = 41;

constexpr size_t WS_WIN = 0;
constexpr size_t WS_WBR = WS_WIN + (size_t)NP * 1024 * 2;
constexpr size_t WS_WO = WS_WBR + (size_t)3072 * 1024 * 2;
constexpr size_t WS_WUP = WS_WO + (size_t)1024 * 1024 * 2;
constexpr size_t WS_WDN = WS_WUP + (size_t)6144 * 1024 * 2;
constexpr size_t WS_W1T = WS_WDN + (size_t)1024 * 3072 * 2;
constexpr size_t WS_W2T = WS_W1T + (size_t)2 * 128 * 2048 * 2;
constexpr size_t WS_KC = WS_W2T + (size_t)2 * 64 * 128 * 2;
constexpr size_t WS_VC = WS_KC + (size_t)32 * 128 * 64 * 2;
constexpr size_t WS_H = WS_VC + (size_t)32 * 128 * 64 * 2;
constexpr size_t WS_P = WS_H + (size_t)T_ * 1024 * 2;
constexpr size_t WS_O3 = WS_P + (size_t)T_ * NP * 2;
constexpr size_t WS_MF = WS_O3 + (size_t)3 * T_ * 1024 * 2;
constexpr size_t WS_KV = WS_MF + 4096;
constexpr size_t WS_X = WS_MF + (size_t)T_ * 1024 * 4;
constexpr size_t WS_QB = WS_X + (size_t)T_ * 1024 * 2;
constexpr size_t WS_GLA = WS_QB + (size_t)T_ * 1024 * 2;
constexpr size_t WS_GFA = WS_GLA + (size_t)64 * 2 * 1024 * 4;
constexpr size_t WS_END = WS_GFA + (size_t)64 * 2 * 2 * 1024 * 4;
constexpr size_t WS_BAR = WS_MF + (size_t)60 * 1048576;
constexpr size_t WS_GL = WS_MF + (size_t)52 * 1048576;
constexpr size_t WS_GF = WS_GL + (size_t)64 * 2 * DFF * 4;
constexpr size_t KV_TENSOR = (size_t)8 * 4 * S_ * 64;

struct Params { const float* in[21]; float* out; unsigned char* ws; int ph_lo, ph_hi; };

DEV float bf2f(unsigned b) { return __uint_as_float(b << 16); }
DEV float bflo(unsigned u) { return __uint_as_float(u << 16); }
DEV float bfhi(unsigned u) { return __uint_as_float(u & 0xffff0000u); }
DEV unsigned cvt_pk_bf16(float lo, float hi) { unsigned r; asm volatile("v_cvt_pk_bf16_f32 %0, %1, %2" : "=v"(r) : "v"(lo), "v"(hi)); return r; }
DEV float gelu_t(float x) { const float u = x * (0.7978845608f + 0.0356774081f * x * x); return x * __builtin_amdgcn_rcpf(1.f + __builtin_amdgcn_exp2f(-2.885390082f * u)); }
DEV float sigm(float x) { return __builtin_amdgcn_rcpf(1.f + __builtin_amdgcn_exp2f(-1.4426950409f * x)); }
DEV void unpack8(const u32x4 v, float (&f)[8]) { f[0] = bflo(v.x); f[1] = bfhi(v.x); f[2] = bflo(v.y); f[3] = bfhi(v.y); f[4] = bflo(v.z); f[5] = bfhi(v.z); f[6] = bflo(v.w); f[7] = bfhi(v.w); }
DEV u32x4 pack8(const float (&f)[8]) { u32x4 w; w.x = cvt_pk_bf16(f[0], f[1]); w.y = cvt_pk_bf16(f[2], f[3]); w.z = cvt_pk_bf16(f[4], f[5]); w.w = cvt_pk_bf16(f[6], f[7]); return w; }
DEV u32x4 pair32(u32x2 a, u32x2 b) {
    const auto r0 = __builtin_amdgcn_permlane32_swap(a.x, b.x, false, false); const auto r1 = __builtin_amdgcn_permlane32_swap(a.y, b.y, false, false);
    return (u32x4){r0[0], r1[0], r0[1], r1[1]};
}
DEV bf16x8 as_bf16x8(u32x4 v) { union { u32x4 u; bf16x8 b; } x; x.u = v; return x.b; }

namespace pg8 {
constexpr int BM = 256, BK = 64, HALF = 128, HTB = HALF * BK * 2, NXCD = 8, WGM = 8;
DEV int lds_byte(int r, int c) { const int st = (r >> 4) * 2 + (c >> 5), rr = r & 15, cc = c & 31, ob = rr * 64 + cc * 2; return st * 1024 + (ob ^ (((ob >> 9) & 1) << 5)); }
DEV void stage_rc(int b, int& R, int& C) { const int st = b / 1024, sb = b % 1024, swz = sb ^ (((sb >> 9) & 1) << 5); R = (st >> 1) * 16 + swz / 64; C = (st & 1) * 32 + (swz % 64) / 2; }
DEV int perm32(int rho) { const int n = rho >> 4, i = rho & 15; return 8 * (i >> 2) + 4 * n + (i & 3); }
struct Unit { int pm, pn; };
struct Gemm { const bf16_t* A; const bf16_t* Bt; int M, N, K; };

struct StaticOrder {
    int nM, nN, nwg, G, c;
    DEV void init(int M, int N, int G_, int c_) { nM = M / BM; nN = N / BM; nwg = nM * nN; G = G_; c = c_; }
    DEV bool tile(long L, Unit& u) const {
        if (L >= nwg) return false;
        int wgid = (int)L; { const int q = nwg / NXCD, r = nwg % NXCD, xcd = wgid % NXCD, off = wgid / NXCD; wgid = (xcd < r ? xcd * (q + 1) : r * (q + 1) + (xcd - r) * q) + off; }
        const int nig = WGM * nN, gid = wgid / nig, fm = gid * WGM, gsz = (nM - fm) < WGM ? (nM - fm) : WGM;
        u.pm = fm + ((wgid % nig) % gsz); u.pn = (wgid % nig) / gsz; return true;
    }
    DEV bool next(int i, Unit& u) const { return tile((long)i * G + c, u); }
};
struct BranchOrder {
    StaticOrder so;
    DEV void init(int G_, int c_) { so.init(T_, 1024, G_, c_); }
    DEV bool next(int i, Unit& u) const { const int round = i / 3, br = i - round * 3; Unit t; if (!so.tile((long)round * so.G + so.c, t)) return false; u.pm = br * 64 + t.pm; u.pn = br * 4 + t.pn; return true; }
};

struct EpiProj {
    static constexpr bool PERM = true, ROWPERM = true;
    bf16_t* O; int ldc; int act_mode; bf16_t* KV; bf16_t* OA; bf16_t* QB; const float* cwa; float* GLA; float* GFA; LAS unsigned char* ex;
    DEV bool operator()(f32x4 (&acc)[2][2][4][2], const Unit& u, int wr, int wc, int fr, int fq) const {
        const int row0 = u.pm * BM + (16 * wr + fr) * 8, col0 = u.pn * BM + wc * 32 + 8 * fq;
        const int act = act_mode ? 0 : (u.pn < 22 ? 0 : (u.pn < 26 ? 1 : 2));
        const bool kvt = !act_mode && u.pn >= 16 && u.pn < 22;
        if (!act_mode && u.pn >= 26 && u.pn < 42) {
            const int chb = (u.pn - 26) * 64 + wc * 16 + (fq & 1) * 8, up = fq >> 1;
#pragma unroll
            for (int ai = 0; ai < 2; ++ai)
#pragma unroll
                for (int mp = 0; mp < 2; ++mp) { u32x2 pk[2][4];
#pragma unroll
                    for (int mm = 0; mm < 2; ++mm) { const int m = mp * 2 + mm; float f0[4], f1[4], f2[4], uu[4];
#pragma unroll
                        for (int j = 0; j < 4; ++j) { const float s0 = sigm(acc[ai][0][m][0][j]), s1 = fmaxf(sigm(acc[ai][0][m][1][j]), 1e-12f), s2 = fmaxf(sigm(acc[ai][1][m][0][j]), 1e-12f);
                            f0[j] = s0 * __builtin_amdgcn_rcpf(s1); f1[j] = s1 * __builtin_amdgcn_rcpf(s2); f2[j] = s2; uu[j] = gelu_t(acc[ai][1][m][1][j]); }
                        pk[mm][0].x = cvt_pk_bf16(f0[0], f0[1]); pk[mm][0].y = cvt_pk_bf16(f0[2], f0[3]); pk[mm][1].x = cvt_pk_bf16(f1[0], f1[1]); pk[mm][1].y = cvt_pk_bf16(f1[2], f1[3]);
                        pk[mm][2].x = cvt_pk_bf16(f2[0], f2[1]); pk[mm][2].y = cvt_pk_bf16(f2[2], f2[3]); pk[mm][3].x = cvt_pk_bf16(uu[0], uu[1]); pk[mm][3].y = cvt_pk_bf16(uu[2], uu[3]); }
                    bf16_t* rp = O + (size_t)(row0 + ai * 4 + mp * 2 + up) * ldc + chb;
                    *(u32x4*)(rp + COL_G0) = pair32(pk[0][0], pk[1][0]);
                    *(u32x4*)(rp + COL_G0 + 1024) = pair32(pk[0][1], pk[1][1]);
                    *(u32x4*)(rp + COL_G0 + 2048) = pair32(pk[0][2], pk[1][2]);
                    *(u32x4*)(rp + COL_U) = pair32(pk[0][3], pk[1][3]); }
            return true;
        }
        if (!act_mode && u.pn < 16) {
            const int ch0 = u.pn * 64 + wc * 16 + (fq & 1) * 8 + (fq >> 1) * 4, chb = u.pn * 64 + wc * 16 + (fq & 1) * 8, up = fq >> 1;
            f32x4 w[3];
#pragma unroll
            for (int k = 0; k < 3; ++k) w[k] = *(const f32x4*)(cwa + k * 1024 + ch0);
            f32x4 xp[8];
#pragma unroll
            for (int i = 0; i < 8; ++i) xp[i] = acc[i >> 2][0][i & 3][1] * acc[i >> 2][1][i & 3][0];
            f32x4 p6, p7;
#pragma unroll
            for (int c = 0; c < 4; ++c) { p6[c] = __shfl_up(xp[6][c], 1); p7[c] = __shfl_up(xp[7][c], 1); }
            LAS f32x4* EX = (LAS f32x4*)ex + (wc * 4 + fq) * 2;
            if (wr == 0 && fr == 15) { EX[0] = xp[6]; EX[1] = xp[7]; }
            asm volatile("s_waitcnt lgkmcnt(0)" ::: "memory"); __builtin_amdgcn_s_barrier(); asm volatile("" ::: "memory");
            if (wr == 1 && fr == 0) { p6 = EX[0]; p7 = EX[1]; }
            if (wr == 1 && fr == 15) { float* gl = GLA + (size_t)u.pm * 2 * 1024 + ch0; *(f32x4*)gl = xp[6]; *(f32x4*)(gl + 1024) = xp[7]; }
            const bool halo = (wr == 0 && fr == 0);
            if (halo) {
#pragma unroll
                for (int t = 0; t < 2; ++t) { float* gf = GFA + ((size_t)(u.pm * 2 + t) * 2) * 1024 + ch0; *(f32x4*)gf = acc[0][0][t][0]; *(f32x4*)(gf + 1024) = xp[t]; } }
#pragma unroll
            for (int ip = 0; ip < 4; ++ip) { u32x2 o[2], q2[2];
#pragma unroll
                for (int ii = 0; ii < 2; ++ii) { const int i = ip * 2 + ii;
                    const f32x4 xm1 = i >= 1 ? xp[i >= 1 ? i - 1 : 0] : p7, xm2 = i >= 2 ? xp[i >= 2 ? i - 2 : 0] : (i == 0 ? p6 : p7);
                    const f32x4 y = acc[i >> 2][0][i & 3][0] * (w[0] * xm2 + w[1] * xm1 + w[2] * xp[i]);
                    o[ii].x = cvt_pk_bf16(y[0], y[1]); o[ii].y = cvt_pk_bf16(y[2], y[3]);
                    const f32x4 qv = acc[i >> 2][1][i & 3][1];
                    q2[ii].x = cvt_pk_bf16(qv[0], qv[1]); q2[ii].y = cvt_pk_bf16(qv[2], qv[3]); }
                const size_t tok = (size_t)(row0 + ip * 2 + up);
                const u32x4 ow = pair32(o[0], o[1]), qw = pair32(q2[0], q2[1]);
                if (!(halo && ip == 0)) *(u32x4*)(OA + tok * 1024 + chb) = ow;
                *(u32x4*)(QB + tok * 1024 + chb) = qw; }
            return true;
        }
#pragma unroll
        for (int ai = 0; ai < 2; ++ai)
#pragma unroll
            for (int m = 0; m < 4; ++m) { const int row = row0 + ai * 4 + m; bf16_t* rowp = O + (size_t)row * ldc + col0 + ((!act_mode && u.pn >= 22 && u.pn < 26) ? 1024 : 0);
                if (kvt) rowp = KV + (size_t)(u.pn - 16) * KV_TENSOR + ((size_t)((row >> 11) * 4) * S_ + (row & (S_ - 1))) * 64 + (size_t)(wc >> 1) * S_ * 64 + (wc & 1) * 32 + 8 * fq;
#pragma unroll
                for (int bj = 0; bj < 2; ++bj) { float v[8];
#pragma unroll
                    for (int j = 0; j < 4; ++j) { v[j] = acc[ai][bj][m][0][j]; v[4 + j] = acc[ai][bj][m][1][j]; }
                    if (act == 1) {
#pragma unroll
                        for (int j = 0; j < 8; ++j) v[j] = gelu_t(v[j]); }
                    else if (act == 2) {
#pragma unroll
                        for (int j = 0; j < 8; ++j) v[j] = sigm(v[j]); }
                    *(u32x4*)(rowp + (kvt ? (size_t)bj * 2 * S_ * 64 : (size_t)bj * HALF)) = pack8(v); } }
        return true;
    }
};
struct EpiBranch {
    static constexpr bool PERM = true, ROWPERM = false;
    const bf16_t* P; bf16_t* MB;
    DEV bool operator()(f32x4 (&acc)[2][2][4][2], const Unit& u, int wr, int wc, int fr, int fq) const {
        const int br = u.pn >> 2, pn = u.pn & 3, pm = u.pm - br * 64;
        const int row0 = pm * BM + wr * 64 + fr, col0 = pn * BM + wc * 32 + 8 * fq;
#pragma unroll
        for (int ai = 0; ai < 2; ++ai) {
            u32x4 ga[4][2];
#pragma unroll
            for (int m = 0; m < 4; ++m)
#pragma unroll
                for (int bj = 0; bj < 2; ++bj) ga[m][bj] = *(const u32x4*)(P + (size_t)(row0 + ai * HALF + m * 16) * NP + COL_G0 + br * 1024 + col0 + bj * HALF);
#pragma unroll
            for (int m = 0; m < 4; ++m)
#pragma unroll
                for (int bj = 0; bj < 2; ++bj) { const size_t row = (size_t)(row0 + ai * HALF + m * 16);
                    float f[8], v[8]; unpack8(ga[m][bj], f);
#pragma unroll
                    for (int j = 0; j < 4; ++j) { v[j] = acc[ai][bj][m][0][j] * f[j]; v[4 + j] = acc[ai][bj][m][1][j] * f[4 + j]; }
                    if (br < 2) { acc[ai][bj][m][0] = (f32x4){v[0], v[1], v[2], v[3]}; acc[ai][bj][m][1] = (f32x4){v[4], v[5], v[6], v[7]}; }
                    else *(u32x4*)(MB + row * 1024 + col0 + bj * HALF) = pack8(v); }
        }
        return br == 2;
    }
};
struct EpiRes {
    static constexpr bool PERM = true, ROWPERM = false;
    bf16_t* X;
    DEV bool operator()(f32x4 (&acc)[2][2][4][2], const Unit& u, int wr, int wc, int fr, int fq) const {
        const int row0 = u.pm * BM + wr * 64 + fr, col0 = u.pn * BM + wc * 32 + 8 * fq;
#pragma unroll
        for (int ai = 0; ai < 2; ++ai) {
            u32x4 old[4][2];
#pragma unroll
            for (int m = 0; m < 4; ++m)
#pragma unroll
                for (int bj = 0; bj < 2; ++bj) old[m][bj] = *(const u32x4*)(X + (size_t)(row0 + ai * HALF + m * 16) * 1024 + col0 + bj * HALF);
#pragma unroll
            for (int m = 0; m < 4; ++m)
#pragma unroll
                for (int bj = 0; bj < 2; ++bj) { float v[8]; unpack8(old[m][bj], v);
#pragma unroll
                    for (int j = 0; j < 4; ++j) { v[j] += acc[ai][bj][m][0][j]; v[4 + j] += acc[ai][bj][m][1][j]; }
                    *(u32x4*)(X + (size_t)(row0 + ai * HALF + m * 16) * 1024 + col0 + bj * HALF) = pack8(v); }
        }
        return true;
    }
};
struct EpiAct {
    static constexpr bool PERM = true, ROWPERM = true;
    bf16_t* ACT; const float* cw; float* GL; float* GF; LAS unsigned char* ex;
    DEV bool operator()(f32x4 (&acc)[2][2][4][2], const Unit& u, int wr, int wc, int fr, int fq) const {
        const int ch0 = u.pn * 128 + wc * 32 + 8 * fq;
        float w[3][8];
#pragma unroll
        for (int k = 0; k < 3; ++k) { const f32x4 w0 = *(const f32x4*)(cw + k * DFF + ch0), w1 = *(const f32x4*)(cw + k * DFF + ch0 + 4);
#pragma unroll
            for (int j = 0; j < 4; ++j) { w[k][j] = w0[j]; w[k][4 + j] = w1[j]; } }
        float p6[8], p7[8];
#pragma unroll
        for (int c = 0; c < 8; ++c) { p6[c] = __shfl_up(acc[1][0][2][c >> 2][c & 3], 1); p7[c] = __shfl_up(acc[1][0][3][c >> 2][c & 3], 1); }
        LAS float* EX = (LAS float*)ex + (wc * 4 + fq) * 16;
        if (wr == 0 && fr == 15) {
#pragma unroll
            for (int c = 0; c < 8; ++c) { EX[c] = acc[1][0][2][c >> 2][c & 3]; EX[8 + c] = acc[1][0][3][c >> 2][c & 3]; }
        }
        asm volatile("s_waitcnt lgkmcnt(0)" ::: "memory"); __builtin_amdgcn_s_barrier(); asm volatile("" ::: "memory");
        if (wr == 1 && fr == 0) {
#pragma unroll
            for (int c = 0; c < 8; ++c) { p6[c] = EX[c]; p7[c] = EX[8 + c]; } }
        if (wr == 1 && fr == 15) { float* gl = GL + (size_t)u.pm * 2 * DFF + ch0;
            *(f32x4*)gl = acc[1][0][2][0]; *(f32x4*)(gl + 4) = acc[1][0][2][1]; *(f32x4*)(gl + DFF) = acc[1][0][3][0]; *(f32x4*)(gl + DFF + 4) = acc[1][0][3][1]; }
        const bool halo = (wr == 0 && fr == 0);
        if (halo) {
#pragma unroll
            for (int t = 0; t < 2; ++t) { float* gf = GF + ((size_t)(u.pm * 2 + t) * 2) * DFF + ch0;
                *(f32x4*)gf = acc[0][0][t][0]; *(f32x4*)(gf + 4) = acc[0][0][t][1]; *(f32x4*)(gf + DFF) = acc[0][1][t][0]; *(f32x4*)(gf + DFF + 4) = acc[0][1][t][1]; } }
        bf16_t* outp = ACT + ((size_t)u.pm * BM + (size_t)(16 * wr + fr) * 8) * DFF + ch0;
#pragma unroll
        for (int i = 0; i < 8; ++i) { float y[8];
#pragma unroll
            for (int c = 0; c < 8; ++c) {
                const float g0 = acc[i >> 2][0][i & 3][c >> 2][c & 3];
                const float gm1 = i >= 1 ? acc[(i - 1 < 0 ? 0 : i - 1) >> 2][0][(i - 1 < 0 ? 0 : i - 1) & 3][c >> 2][c & 3] : p7[c];
                const float gm2 = i >= 2 ? acc[(i - 2 < 0 ? 0 : i - 2) >> 2][0][(i - 2 < 0 ? 0 : i - 2) & 3][c >> 2][c & 3] : (i == 0 ? p6[c] : p7[c]);
                y[c] = gelu_t(w[0][c] * gm2 + w[1][c] * gm1 + w[2][c] * g0) * acc[i >> 2][1][i & 3][c >> 2][c & 3]; }
            if (!(halo && i < 2)) *(u32x4*)(outp + (size_t)i * DFF) = pack8(y); }
        return true;
    }
};

template <bool ALIGN_EPI, class Epi, class Sched>
DEV void gemm_phase(LAS unsigned char* lds, const Gemm g, const Sched& S, const Epi& E) {
    int tid = threadIdx.x; OPQV(tid);
    const int wid = __builtin_amdgcn_readfirstlane(tid >> 6), lane = tid & 63, wr = wid >> 2, wc = wid & 3, fr = lane & 15, fq = lane >> 4;
    const int K = g.K, nt = K / BK;
    unsigned voffA[2], voffB[2];
#pragma unroll
    for (int i = 0; i < 2; ++i) { int R, C; stage_rc(tid * 16 + i * 8192, R, C); const int Rb = Epi::PERM ? ((R & ~31) + perm32(R & 31)) : R;
        const int Ra = Epi::ROWPERM ? (((R >> 6) * 16 + (R & 15)) * 8 + ((R >> 4) & 3)) : R;
        voffA[i] = (unsigned)(Ra * K + C) * 2u; voffB[i] = (unsigned)(Rb * K + C) * 2u; }
    const size_t kstep = (size_t)(BK * 2);
    const size_t hstep = (size_t)HALF * K * 2;
    const size_t hstepA = Epi::ROWPERM ? (size_t)4 * K * 2 : hstep;
    const size_t tstep = 2 * hstep;
    const unsigned ldsw = (unsigned)wid * 1024u;
    const int aoff = lds_byte(wr * 64 + fr, fq * 8), boff = lds_byte(wc * 32 + fr, fq * 8);
#define PG8_SA(b, h) (((b) * 2 + (h)) * HTB)
#define PG8_SB(b, h) ((4 + (b) * 2 + (h)) * HTB)
#define PG8_STAGE(bufoff, gbase, voff) do { _Pragma("unroll") for (int _i = 0; _i < 2; ++_i) \
        __builtin_amdgcn_global_load_lds((const unsigned*)((const char*)(gbase) + (voff)[_i]), (LAS unsigned*)(lds + (bufoff) + ldsw + _i * 8192), 16, 0, 0); } while (0)
#define PG8_LDA(dst, b, h) do { _Pragma("unroll") for (int m = 0; m < 4; ++m) _Pragma("unroll") for (int k = 0; k < 2; ++k) dst[m][k] = *(const LAS bf16x8*)(lds + PG8_SA(b, h) + aoff + m * 2048 + k * 1024); } while (0)
#define PG8_LDB(dst, b, h) do { _Pragma("unroll") for (int n = 0; n < 2; ++n) _Pragma("unroll") for (int k = 0; k < 2; ++k) dst[n][k] = *(const LAS bf16x8*)(lds + PG8_SB(b, h) + boff + n * 2048 + k * 1024); } while (0)
#define PG8_MMA(ai, bj, At, Bt) do { __builtin_amdgcn_s_setprio(1); _Pragma("unroll") for (int m = 0; m < 4; ++m) _Pragma("unroll") for (int n = 0; n < 2; ++n) _Pragma("unroll") for (int k = 0; k < 2; ++k) \
        acc[ai][bj][m][n] = __builtin_amdgcn_mfma_f32_16x16x32_bf16(Bt[n][k], At[m][k], acc[ai][bj][m][n], 0, 0, 0); __builtin_amdgcn_s_setprio(0); } while (0)
#define PG8_WAIT_V(n) asm volatile("s_waitcnt vmcnt(" #n ")" ::: "memory")
#define PG8_WAIT_L(n) asm volatile("s_waitcnt lgkmcnt(" #n ")" ::: "memory")
#define PG8_BAR __builtin_amdgcn_s_barrier()
#define PG8_SCHED __builtin_amdgcn_sched_barrier(0)
    Unit cur, nxt; int ui = 0;
    if (!S.next(0, cur)) return;
    f32x4 acc[2][2][4][2];
#pragma unroll
    for (int a = 0; a < 2; ++a)
#pragma unroll
        for (int b = 0; b < 2; ++b)
#pragma unroll
            for (int m = 0; m < 4; ++m)
#pragma unroll
                for (int n = 0; n < 2; ++n) acc[a][b][m][n] = (f32x4){0.f, 0.f, 0.f, 0.f};
    bf16x8 At[4][2], B0[2][2], B1[2][2];
    const char* cA = (const char*)g.A + (size_t)cur.pm * tstep; const char* cB = (const char*)g.Bt + (size_t)cur.pn * tstep;
    PG8_STAGE(PG8_SB(0, 0), cB, voffB); PG8_STAGE(PG8_SB(0, 1), cB + hstep, voffB); PG8_STAGE(PG8_SA(0, 0), cA, voffA); PG8_STAGE(PG8_SA(0, 1), cA + hstepA, voffA);
    if (wr == 1) PG8_BAR;
    PG8_WAIT_V(2); PG8_BAR;
    PG8_STAGE(PG8_SB(1, 0), cB + kstep, voffB); PG8_STAGE(PG8_SA(1, 0), cA + kstep, voffA); PG8_STAGE(PG8_SB(1, 1), cB + hstep + kstep, voffB);
    PG8_WAIT_V(6); PG8_BAR;
    for (;;) {
        const bool has_next = S.next(ui + 1, nxt);
        const char* nA = has_next ? (const char*)g.A + (size_t)nxt.pm * tstep : cA; const char* nB = has_next ? (const char*)g.Bt + (size_t)nxt.pn * tstep : cB;
        for (int t = 0; t < nt; t += 2) {
            const bool last = (t == nt - 2);
            const char* a1 = cA + (size_t)(t + 1) * kstep;
            const char* a2 = last ? nA : cA + (size_t)(t + 2) * kstep; const char* b2 = last ? nB : cB + (size_t)(t + 2) * kstep;
            const char* a3 = a2 + kstep; const char* b3 = b2 + kstep;
            PG8_LDB(B0, 0, 0); PG8_LDB(B1, 0, 1); PG8_SCHED; PG8_LDA(At, 0, 0); PG8_STAGE(PG8_SA(1, 1), a1 + hstepA, voffA);
            PG8_WAIT_V(8); PG8_WAIT_L(0); PG8_BAR; PG8_MMA(0, 0, At, B0); PG8_MMA(0, 1, At, B1); PG8_BAR; PG8_SCHED;
            PG8_LDA(At, 0, 1); PG8_STAGE(PG8_SB(0, 0), b2, voffB); PG8_STAGE(PG8_SB(0, 1), b2 + hstep, voffB); PG8_STAGE(PG8_SA(0, 0), a2, voffA);
            PG8_WAIT_V(8); PG8_WAIT_L(0); PG8_BAR; PG8_MMA(1, 0, At, B0); PG8_MMA(1, 1, At, B1); PG8_BAR; PG8_SCHED;
            PG8_LDB(B0, 1, 0); PG8_LDB(B1, 1, 1); PG8_SCHED; PG8_LDA(At, 1, 0); PG8_STAGE(PG8_SA(0, 1), a2 + hstepA, voffA);
            PG8_WAIT_V(8); PG8_WAIT_L(0); PG8_BAR; PG8_MMA(0, 0, At, B0); PG8_MMA(0, 1, At, B1); PG8_BAR; PG8_SCHED;
            PG8_LDA(At, 1, 1); PG8_STAGE(PG8_SB(1, 0), b3, voffB); PG8_STAGE(PG8_SB(1, 1), b3 + hstep, voffB); PG8_STAGE(PG8_SA(1, 0), a3, voffA);
            PG8_WAIT_V(8); PG8_WAIT_L(0); PG8_BAR; PG8_MMA(1, 0, At, B0); PG8_MMA(1, 1, At, B1); PG8_BAR; PG8_SCHED;
        }
        if (ALIGN_EPI) { if (wr == 0) PG8_BAR; }
        const bool rst = E(acc, cur, wr, wc, fr, fq);
        if (!has_next) break;
        if (rst) {
#pragma unroll
        for (int a = 0; a < 2; ++a)
#pragma unroll
            for (int b = 0; b < 2; ++b)
#pragma unroll
                for (int m = 0; m < 4; ++m)
#pragma unroll
                    for (int n = 0; n < 2; ++n) acc[a][b][m][n] = (f32x4){0.f, 0.f, 0.f, 0.f}; }
        cur = nxt; cA = nA; cB = nB; ++ui;
        if (ALIGN_EPI) { if (wr == 1) PG8_BAR; }
    }
    PG8_WAIT_V(0);
    if (!ALIGN_EPI) { if (wr == 0) PG8_BAR; }
    PG8_BAR;
#undef PG8_SA
#undef PG8_SB
#undef PG8_STAGE
#undef PG8_LDA
#undef PG8_LDB
#undef PG8_MMA
#undef PG8_WAIT_V
#undef PG8_WAIT_L
#undef PG8_BAR
#undef PG8_SCHED
}
}

DEV int map_col(int n, int Nsrc, int mode) {
    if (mode == 1) { if (n < 4096) { const int U = n >> 8, c = n & 255; const int fq = (c >> 3) & 3; const int t = (c >> 7) * 2 + ((c >> 2) & 1), ch = 64 * U + ((c >> 5) & 3) * 16 + (fq & 1) * 8 + (fq >> 1) * 4 + (c & 3); return t * 1024 + ch; }
        if (n < 5632) return n;
        if (n < 6656) return 6704 + (n - 5632);
        if (n < 10752) { const int m = n - 6656, U = m >> 8, c = m & 255;
            const int fq = (c >> 3) & 3; const int t = (c >> 7) * 2 + ((c >> 2) & 1), ch = 64 * U + ((c >> 5) & 3) * 16 + (fq & 1) * 8 + (fq >> 1) * 4 + (c & 3);
            return (t == 0 ? 7728 : t == 1 ? 8752 : t == 2 ? 9776 : 5680) + ch; }
        if (n < 10800) return n - 5120; return -1; }
    if (mode == 2) { const int pn = n >> 8, r = n & 255; return r < 128 ? 128 * pn + r : 3072 + 128 * pn + (r - 128); }
    return n < Nsrc ? n : -1;
}
DEV void lds_barrier() { asm volatile("s_waitcnt lgkmcnt(0)" ::: "memory"); __builtin_amdgcn_s_barrier(); asm volatile("" ::: "memory"); }
template <int NW>
DEV void convT(LAS unsigned char* lds, const float* src, int K, int Nsrc, bf16_t* dst, int Npad, int mode, int rot) {
    LAS float* tile = (LAS float*)lds;
    int tid = threadIdx.x; OPQV(tid); const int G = gridDim.x;
    constexpr int PW = NW + 1, NL = NW * 64 / 512, RPI = 512 / NW, TPN = 512 / NW, KS = 64 / TPN;
    const int ntk = K / 64, ntn = Npad / NW, ntiles = ntk * ntn;
    const int n = tid % NW, kr = tid / NW;
    int tix = (blockIdx.x + G - (rot % G)) % G;
    float ld[NL];
    if (tix < ntiles) { const int n0 = (tix / ntk) * NW, k0 = (tix % ntk) * 64; const int sc = map_col(n0 + n, Nsrc, mode);
#pragma unroll
        for (int i = 0; i < NL; ++i) ld[i] = sc >= 0 ? __builtin_nontemporal_load(src + (size_t)(k0 + i * RPI + kr) * Nsrc + sc) : 0.f; }
    for (; tix < ntiles; tix += G) {
        const int n0 = (tix / ntk) * NW, k0 = (tix % ntk) * 64;
#pragma unroll
        for (int i = 0; i < NL; ++i) tile[(i * RPI + kr) * PW + n] = ld[i];
        lds_barrier();
        const int tnx = tix + G;
        if (tnx < ntiles) { const int n1 = (tnx / ntk) * NW, k1 = (tnx % ntk) * 64; const int sc = map_col(n1 + n, Nsrc, mode);
#pragma unroll
            for (int i = 0; i < NL; ++i) ld[i] = sc >= 0 ? __builtin_nontemporal_load(src + (size_t)(k1 + i * RPI + kr) * Nsrc + sc) : 0.f; }
        { const int nn = tid / TPN, ks = (tid % TPN) * KS;
#pragma unroll
            for (int h = 0; h < KS / 8; ++h) { float v[8];
#pragma unroll
                for (int j = 0; j < 8; ++j) v[j] = tile[(ks + h * 8 + j) * PW + nn];
                *(u32x4*)(dst + (size_t)(n0 + nn) * K + k0 + ks + h * 8) = pack8(v); } }
        lds_barrier();
    }
}
DEV float wave_sum(float v) {
#pragma unroll
    for (int o = 32; o >= 1; o >>= 1) v += __shfl_xor(v, o);
    return v;
}
template <int RB>
DEV void rmsnorm_rows(const float* srcf, const bf16_t* srcb, const float* gamma, bf16_t* H, bf16_t* cpy, float* outn, int row0, int lane) {
    float v[RB][16];
    if (srcf) {
#pragma unroll
        for (int r = 0; r < RB; ++r)
#pragma unroll
            for (int hf = 0; hf < 2; ++hf) { const f32x4 a = *(const f32x4*)(srcf + (size_t)(row0 + r) * 1024 + hf * 512 + lane * 8), b2 = *(const f32x4*)(srcf + (size_t)(row0 + r) * 1024 + hf * 512 + lane * 8 + 4);
#pragma unroll
                for (int j = 0; j < 4; ++j) { v[r][hf * 8 + j] = a[j]; v[r][hf * 8 + 4 + j] = b2[j]; } }
    } else {
        u32x4 raw[RB][2];
#pragma unroll
        for (int r = 0; r < RB; ++r)
#pragma unroll
            for (int hf = 0; hf < 2; ++hf) raw[r][hf] = *(const u32x4*)(srcb + (size_t)(row0 + r) * 1024 + hf * 512 + lane * 8);
#pragma unroll
        for (int r = 0; r < RB; ++r)
#pragma unroll
            for (int hf = 0; hf < 2; ++hf) { float t8[8]; unpack8(raw[r][hf], t8);
#pragma unroll
                for (int j = 0; j < 8; ++j) v[r][hf * 8 + j] = t8[j]; }
    }
    f32x4 g0[2], g1[2];
#pragma unroll
    for (int hf = 0; hf < 2; ++hf) { g0[hf] = *(const f32x4*)(gamma + hf * 512 + lane * 8); g1[hf] = *(const f32x4*)(gamma + hf * 512 + lane * 8 + 4); }
#pragma unroll
    for (int r = 0; r < RB; ++r) {
        float ss = 0.f;
#pragma unroll
        for (int j = 0; j < 16; ++j) ss += v[r][j] * v[r][j];
        ss = wave_sum(ss);
        const float rs = rsqrtf(ss * (1.f / 1024.f) + EPS_);
        const int row = row0 + r;
#pragma unroll
        for (int hf = 0; hf < 2; ++hf) { const int c = hf * 512 + lane * 8;
            float y[8], x8[8];
#pragma unroll
            for (int j = 0; j < 4; ++j) { y[j] = v[r][hf * 8 + j] * rs * g0[hf][j]; y[4 + j] = v[r][hf * 8 + 4 + j] * rs * g1[hf][j]; }
#pragma unroll
            for (int j = 0; j < 8; ++j) x8[j] = v[r][hf * 8 + j];
            if (cpy) *(u32x4*)(cpy + (size_t)row * 1024 + c) = pack8(x8);
            if (outn) { *(f32x4*)(outn + (size_t)row * 1024 + c) = (f32x4){y[0], y[1], y[2], y[3]}; *(f32x4*)(outn + (size_t)row * 1024 + c + 4) = (f32x4){y[4], y[5], y[6], y[7]}; }
            if (H) *(u32x4*)(H + (size_t)row * 1024 + c) = pack8(y); }
    }
}
DEV void phase_rmsnorm(const float* srcf, const bf16_t* srcb, const float* gamma, bf16_t* H, bf16_t* cpy, float* outn) {
    int tid = threadIdx.x; OPQV(tid); const int lane = tid & 63, wave = tid >> 6;
    for (int rq = blockIdx.x * 8 + wave; rq < T_ / 4; rq += gridDim.x * 8) rmsnorm_rows<4>(srcf, srcb, gamma, H, cpy, outn, rq * 4, lane);
}
DEV void phase_rowpass(const bf16_t* P, const float* conv_a, const float* lng, const float* lnb, bf16_t* OA, bf16_t* VN, const float* GLA, const float* GFA) {
    int tid = threadIdx.x; OPQV(tid); const int lane = tid & 63, wave = tid >> 6;
    for (int idx = blockIdx.x * 512 + tid; idx < 64 * 2 * 256; idx += gridDim.x * 512) {
        const int pm = idx >> 9, r = idx & 511, t = r >> 8, c = (r & 255) * 4;
        const bool first = (pm & 7) == 0;
        const float* gf = GFA + ((size_t)(pm * 2 + t) * 2) * 1024 + c;
        const float* gl = GLA + (size_t)(first ? 0 : pm - 1) * 2 * 1024 + c;
        const f32x4 gb = *(const f32x4*)gf, x0 = *(const f32x4*)(gf + 1024);
        f32x4 xm1 = t == 0 ? *(const f32x4*)(gl + 1024) : *(const f32x4*)(GFA + ((size_t)(pm * 2) * 2) * 1024 + 1024 + c);
        f32x4 xm2 = t == 0 ? *(const f32x4*)gl : *(const f32x4*)(gl + 1024);
        if (first) { xm2 = (f32x4){0.f, 0.f, 0.f, 0.f}; if (t == 0) xm1 = xm2; }
        const f32x4 w0 = *(const f32x4*)(conv_a + c), w1 = *(const f32x4*)(conv_a + 1024 + c), w2 = *(const f32x4*)(conv_a + 2048 + c);
        const f32x4 y = gb * (w0 * xm2 + w1 * xm1 + w2 * x0);
        u32x2 o; o.x = cvt_pk_bf16(y[0], y[1]); o.y = cvt_pk_bf16(y[2], y[3]);
        *(u32x2*)(OA + ((size_t)pm * 256 + t) * 1024 + c) = o;
    }
    f32x4 g0[2], g1[2], b0[2], b1[2];
#pragma unroll
    for (int hlf = 0; hlf < 2; ++hlf) { const int c = hlf * 512 + lane * 8; g0[hlf] = *(const f32x4*)(lng + c); g1[hlf] = *(const f32x4*)(lng + c + 4); b0[hlf] = *(const f32x4*)(lnb + c); b1[hlf] = *(const f32x4*)(lnb + c + 4); }
    for (int rp = blockIdx.x * 8 + wave; rp < T_ / 2; rp += gridDim.x * 8) {
        const int row = rp * 2;
        const bf16_t* pr = P + (size_t)row * NP;
        u32x4 vr[2][2];
#pragma unroll
        for (int r = 0; r < 2; ++r)
#pragma unroll
            for (int hlf = 0; hlf < 2; ++hlf) vr[r][hlf] = *(const u32x4*)(pr + (size_t)r * NP + COL_V + hlf * 512 + lane * 8);
#pragma unroll
        for (int r = 0; r < 2; ++r) {
            float v[2][8]; float sm = 0.f;
#pragma unroll
            for (int hlf = 0; hlf < 2; ++hlf) { unpack8(vr[r][hlf], v[hlf]);
#pragma unroll
                for (int j = 0; j < 8; ++j) sm += v[hlf][j]; }
            const float mu = wave_sum(sm) * (1.f / 1024.f);
            float q = 0.f;
#pragma unroll
            for (int hlf = 0; hlf < 2; ++hlf)
#pragma unroll
                for (int j = 0; j < 8; ++j) { const float d = v[hlf][j] - mu; q += d * d; }
            const float rstd = rsqrtf(wave_sum(q) * (1.f / 1024.f) + EPS_);
#pragma unroll
            for (int hlf = 0; hlf < 2; ++hlf) { const int c = hlf * 512 + lane * 8; float o[8];
#pragma unroll
                for (int j = 0; j < 4; ++j) { o[j] = (v[hlf][j] - mu) * rstd * g0[hlf][j] + b0[hlf][j]; o[4 + j] = (v[hlf][4 + j] - mu) * rstd * g1[hlf][j] + b1[hlf][j]; }
                *(u32x4*)(VN + (size_t)(row + r) * 1024 + c) = pack8(o); }
        }
    }
}
DEV void phase_compress(LAS unsigned char* lds, const bf16_t* KV, const float* pos  , const bf16_t* W1T, const bf16_t* W2T, bf16_t* KC, bf16_t* VC) {
    int tid = threadIdx.x; OPQV(tid); const int lane = tid & 63, wv = tid >> 6, fr = lane & 15, g4 = lane >> 4;
    constexpr int PP = 132, HIDO = 4 * 32 * PP * 4;
    LAS float* PART = (LAS float*)lds;
    LAS bf16_t* HID = (LAS bf16_t*)(lds + HIDO);
    for (int item = blockIdx.x; item < 256; item += gridDim.x) {
        const int w = item >> 7, b = (item >> 4) & 7, g = (item >> 2) & 3, qr = item & 3;
        const int kq = wv >> 1, nh = wv & 1;
        const float* posw = pos + w * 2048;
        const bf16_t* w1 = W1T + (size_t)w * 128 * 2048 + (size_t)(nh * 64 + fr) * 2048 + g4 * 8;
        f32x4 acc[2][4];
#pragma unroll
        for (int mt = 0; mt < 2; ++mt)
#pragma unroll
            for (int nt = 0; nt < 4; ++nt) acc[mt][nt] = (f32x4){0.f, 0.f, 0.f, 0.f};
        const int n0 = qr * 32 + fr, n1 = n0 + 16;
        const bool ok0 = n0 < 127, ok1 = n1 < 127;
        const bf16_t* x0 = KV + (size_t)w * KV_TENSOR + ((size_t)(b * 4 + g) * S_ + 16 * min(n0, 126)) * 64 + g4 * 8;
        const bf16_t* x1 = KV + (size_t)w * KV_TENSOR + ((size_t)(b * 4 + g) * S_ + 16 * min(n1, 126)) * 64 + g4 * 8;
#pragma unroll 4
        for (int ks = 0; ks < 16; ++ks) { const int kk = kq * 16 + ks, i = kk >> 1, db = (kk & 1) * 32;
            const f32x4 p0 = *(const f32x4*)(posw + i * 64 + db + g4 * 8), p1 = *(const f32x4*)(posw + i * 64 + db + g4 * 8 + 4);
            const u32x4 xa = *(const u32x4*)(x0 + i * 64 + db);
            const u32x4 xb = *(const u32x4*)(x1 + i * 64 + db);
            bf16x8 bfr[4];
#pragma unroll
            for (int nt = 0; nt < 4; ++nt) bfr[nt] = *(const bf16x8*)(w1 + (size_t)nt * 16 * 2048 + kk * 32);
            float a[8];
            unpack8(xa, a);
#pragma unroll
            for (int j = 0; j < 4; ++j) { a[j] += p0[j]; a[4 + j] += p1[j]; }
#pragma unroll
            for (int j = 0; j < 8; ++j) a[j] = ok0 ? a[j] : 0.f;
            const bf16x8 af0 = as_bf16x8(pack8(a));
            unpack8(xb, a);
#pragma unroll
            for (int j = 0; j < 4; ++j) { a[j] += p0[j]; a[4 + j] += p1[j]; }
#pragma unroll
            for (int j = 0; j < 8; ++j) a[j] = ok1 ? a[j] : 0.f;
            const bf16x8 af1 = as_bf16x8(pack8(a));
#pragma unroll
            for (int nt = 0; nt < 4; ++nt) { acc[0][nt] = __builtin_amdgcn_mfma_f32_16x16x32_bf16(af0, bfr[nt], acc[0][nt], 0, 0, 0);
                acc[1][nt] = __builtin_amdgcn_mfma_f32_16x16x32_bf16(af1, bfr[nt], acc[1][nt], 0, 0, 0); }
        }
#pragma unroll
        for (int mt = 0; mt < 2; ++mt)
#pragma unroll
            for (int nt = 0; nt < 4; ++nt)
#pragma unroll
                for (int r = 0; r < 4; ++r) PART[(kq * 32 + mt * 16 + g4 * 4 + r) * PP + nh * 64 + nt * 16 + fr] = acc[mt][nt][r];
        __syncthreads();
        { const int row = tid >> 4, c8 = (tid & 15) * 8; float hv[8];
#pragma unroll
            for (int j = 0; j < 8; ++j) hv[j] = 0.f;
#pragma unroll
            for (int q = 0; q < 4; ++q) { const f32x4 u0 = *(const LAS f32x4*)(lds + ((q * 32 + row) * PP + c8) * 4), u1 = *(const LAS f32x4*)(lds + ((q * 32 + row) * PP + c8 + 4) * 4);
#pragma unroll
                for (int j = 0; j < 4; ++j) { hv[j] += u0[j]; hv[4 + j] += u1[j]; } }
#pragma unroll
            for (int j = 0; j < 8; ++j) hv[j] = gelu_t(hv[j]);
            *(LAS u32x4*)(lds + HIDO + (row * 136 + c8) * 2) = pack8(hv); }
        __syncthreads();
        { const int mt = wv >> 2, dt = wv & 3;
            const bf16_t* w2 = W2T + (size_t)w * 64 * 128 + (size_t)(dt * 16 + fr) * 128;
            f32x4 o = (f32x4){0.f, 0.f, 0.f, 0.f};
#pragma unroll
            for (int ks = 0; ks < 4; ++ks) { const bf16x8 af = *(const LAS bf16x8*)(lds + HIDO + ((mt * 16 + fr) * 136 + ks * 32 + g4 * 8) * 2);
                const bf16x8 bfr = *(const bf16x8*)(w2 + ks * 32 + g4 * 8);
                o = __builtin_amdgcn_mfma_f32_16x16x32_bf16(af, bfr, o, 0, 0, 0); }
            bf16_t* dst = (w ? VC : KC) + (size_t)(b * 4 + g) * 128 * 64;
#pragma unroll
            for (int r = 0; r < 4; ++r) { const int n = qr * 32 + mt * 16 + g4 * 4 + r; const float ov = n < 127 ? o[r] : 0.f;
                dst[n * 64 + dt * 16 + fr] = (bf16_t)(cvt_pk_bf16(ov, 0.f) & 0xffffu); } }
        __syncthreads();
    }
}
DEV void sgu_item(LAS unsigned char* lds, const bf16_t* P, const bf16_t* VN, const float* sgu_w, const float* sgu_b, bf16_t* OC, int item) {
    int tid = threadIdx.x; OPQV(tid); const int lane = tid & 63, wv = tid >> 6, fr = lane & 15, g4 = lane >> 4;
    LAS bf16_t* VT = (LAS bf16_t*)lds;
    const int g = item & 7, ch = (item >> 3) & 15, b = item >> 7;
    const size_t tok0 = (size_t)b * S_ + ch * 128;
    const int t = wv * 16 + fr;
    const size_t tok = tok0 + t;
    u32x4 vin[4];
#pragma unroll
    for (int it = 0; it < 4; ++it) { const int idx = it * 512 + tid, s = idx >> 4, c8 = (idx & 15) * 8; vin[it] = *(const u32x4*)(VN + (tok0 + s) * 1024 + g * 128 + c8); }
    const float* wrow = sgu_w + ((size_t)g * 128 + t) * 128;
    f32x4 wa[4], wb[4];
#pragma unroll
    for (int ks = 0; ks < 4; ++ks) { wa[ks] = *(const f32x4*)(wrow + ks * 32 + g4 * 8); wb[ks] = *(const f32x4*)(wrow + ks * 32 + g4 * 8 + 4); }
    u32x2 uu[8];
#pragma unroll
    for (int n = 0; n < 8; ++n) uu[n] = *(const u32x2*)(P + tok * NP + COL_U + g * 128 + n * 16 + g4 * 4);
    const float bias = sgu_b[g * 128 + t];
#pragma unroll
    for (int it = 0; it < 4; ++it) { const int idx = it * 512 + tid, s = idx >> 4, c8 = (idx & 15) * 8;
#pragma unroll
        for (int j = 0; j < 4; ++j) { VT[(c8 + 2 * j) * 136 + s] = (bf16_t)(vin[it][j] & 0xffffu); VT[(c8 + 2 * j + 1) * 136 + s] = (bf16_t)(vin[it][j] >> 16); } }
    __syncthreads();
    f32x4 acc[8];
#pragma unroll
    for (int n = 0; n < 8; ++n) acc[n] = (f32x4){0.f, 0.f, 0.f, 0.f};
#pragma unroll
    for (int ks = 0; ks < 4; ++ks) { const int s0 = ks * 32 + g4 * 8;
        float wf[8] = {wa[ks][0], wa[ks][1], wa[ks][2], wa[ks][3], wb[ks][0], wb[ks][1], wb[ks][2], wb[ks][3]};
#pragma unroll
        for (int j = 0; j < 8; ++j) if (s0 + j > t) wf[j] = 0.f;
        const bf16x8 wfr = as_bf16x8(pack8(wf));
#pragma unroll
        for (int n = 0; n < 8; ++n) { const bf16x8 vf = *(const LAS bf16x8*)(lds + ((n * 16 + fr) * 136 + s0) * 2);
            acc[n] = __builtin_amdgcn_mfma_f32_16x16x32_bf16(vf, wfr, acc[n], 0, 0, 0); } }
#pragma unroll
    for (int n = 0; n < 8; ++n) { const int c = g * 128 + n * 16 + g4 * 4;
        u32x2 w; w.x = cvt_pk_bf16(bflo(uu[n].x) * (acc[n][0] + bias), bfhi(uu[n].x) * (acc[n][1] + bias)); w.y = cvt_pk_bf16(bflo(uu[n].y) * (acc[n][2] + bias), bfhi(uu[n].y) * (acc[n][3] + bias));
        *(u32x2*)(OC + tok * 1024 + c) = w; }
    __syncthreads();
}
DEV void phase_actfix(const float* GL, const float* GF, const float* cw, bf16_t* ACT, int pm0, int npm) {
    int tid = threadIdx.x; OPQV(tid);
    for (int idx = tid; idx < npm * 768; idx += 512) {
        const int pm = pm0 + idx / 768, r = idx % 768, t = r / 384, c = (r - t * 384) * 8;
        const bool first = (pm & 7) == 0;
        const float* gf = GF + ((size_t)(pm * 2 + t) * 2) * DFF + c;
        const float* gl = GL + (size_t)(first ? 0 : pm - 1) * 2 * DFF + c;
        const float* gm1p = t == 0 ? gl + DFF : GF + ((size_t)(pm * 2) * 2) * DFF + c;
        const float* gm2p = t == 0 ? gl : gl + DFF;
        float y[8];
#pragma unroll
        for (int hf = 0; hf < 2; ++hf) { const f32x4 g0 = *(const f32x4*)(gf + hf * 4), vv = *(const f32x4*)(gf + DFF + hf * 4);
            f32x4 gm1 = *(const f32x4*)(gm1p + hf * 4), gm2 = *(const f32x4*)(gm2p + hf * 4);
            if (first) { gm2 = (f32x4){0.f, 0.f, 0.f, 0.f}; if (t == 0) gm1 = gm2; }
            const f32x4 w0 = *(const f32x4*)(cw + c + hf * 4), w1 = *(const f32x4*)(cw + DFF + c + hf * 4), w2 = *(const f32x4*)(cw + 2 * DFF + c + hf * 4);
#pragma unroll
            for (int j = 0; j < 4; ++j) y[hf * 4 + j] = gelu_t(w0[j] * gm2[j] + w1[j] * gm1[j] + w2[j] * g0[j]) * vv[j]; }
        *(u32x4*)(ACT + ((size_t)pm * 256 + t) * DFF + c) = pack8(y);
    }
}

constexpr int AT_KS = 0, AT_VT = 18432, AT_BT = 36864, AT_BK = 38944, AT_IMP = 39936, AT_MASK = 72704, AT_IMPF = 72960, AT_RB = 81152, AT_NEXT = 83200;

struct KVRegs { u32x4 k, v; };
DEV KVRegs kv_fetch(const bf16_t* kbase, const bf16_t* vbase, int tid) {
    KVRegs r;
    r.k = *(const u32x4*)(kbase + tid * 8); r.v = *(const u32x4*)(vbase + (tid & 63) * 64 + (tid >> 6) * 8); return r;
}
DEV void kv_store(LAS unsigned char* lds, const KVRegs& r, int buf, int tid) {
    const int key = tid >> 3, c8 = (tid & 7) * 8;
    unsigned kw = AT_KS + buf * 9216 + (key * 72 + c8) * 2, vw = AT_VT + buf * 9216 + ((tid >> 6) * 8 * 72 + (tid & 63)) * 2; OPQV(kw); OPQV(vw);
    *(LAS u32x4*)(lds + kw) = r.k;
#pragma unroll
    for (int j = 0; j < 4; ++j) { *(LAS bf16_t*)(lds + vw + j * 288) = (bf16_t)(r.v[j] & 0xffffu); *(LAS bf16_t*)(lds + vw + j * 288 + 144) = (bf16_t)(r.v[j] >> 16); }
}

DEV void attn_tile(LAS unsigned char* lds, const bf16x8 (&qf)[2][2], int tl, int kpos0, int mode, bool near, bool rowsel, const float (&cbias)[2],
                   unsigned kb, unsigned vb_, unsigned btb, int g4, float (&mrun)[2], float (&lrun)[2], f32x4 (&O)[2][4]) {
    f32x4 sc[2][4];
    float ci[2];
#pragma unroll
    for (int hh = 0; hh < 2; ++hh) { const float mne = mrun[hh] < -1e29f ? 0.f : mrun[hh];
        ci[hh] = near ? -mne : (((mode == 1 && !rowsel) ? NEG_ : cbias[hh]) - mne); }
    {
        bf16x8 kf[4][2];
#pragma unroll
        for (int kt = 0; kt < 4; ++kt) { kf[kt][0] = *(const LAS bf16x8*)(lds + kb + kt * 2304); kf[kt][1] = *(const LAS bf16x8*)(lds + kb + kt * 2304 + 64); }
        __builtin_amdgcn_sched_barrier(0);
#pragma unroll
        for (int kt = 0; kt < 4; ++kt)
#pragma unroll
            for (int hh = 0; hh < 2; ++hh) sc[hh][kt] = __builtin_amdgcn_mfma_f32_16x16x32_bf16(kf[kt][0], qf[hh][0], (f32x4){ci[hh], ci[hh], ci[hh], ci[hh]}, 0, 0, 0);
#pragma unroll
        for (int kt = 0; kt < 4; ++kt)
#pragma unroll
            for (int hh = 0; hh < 2; ++hh) sc[hh][kt] = __builtin_amdgcn_mfma_f32_16x16x32_bf16(kf[kt][1], qf[hh][1], sc[hh][kt], 0, 0, 0);
    }
    if (near) {
#pragma unroll
        for (int kt = 0; kt < 4; ++kt)
#pragma unroll
            for (int r = 0; r < 4; ++r) { const int dist = tl - (kpos0 + kt * 16 + g4 * 4 + r);
                const bool valid = dist >= 0 && (mode == 1 ? rowsel : dist < 512);
                const int idx = dist < 0 ? 0 : (dist > 128 ? 128 : dist);
#pragma unroll
                for (int hh = 0; hh < 2; ++hh) { const float s = sc[hh][kt][r] + *(const LAS float*)(lds + btb + idx * 4 + hh * 516); sc[hh][kt][r] = valid ? s : NEG_; } }
    }
    bf16x8 pf[2][2];
#pragma unroll
    for (int hh = 0; hh < 2; ++hh) {
        float lm = fmaxf(fmaxf(sc[hh][0][0], sc[hh][0][1]), fmaxf(sc[hh][0][2], sc[hh][0][3]));
#pragma unroll
        for (int kt = 1; kt < 4; ++kt) lm = fmaxf(lm, fmaxf(fmaxf(sc[hh][kt][0], sc[hh][kt][1]), fmaxf(sc[hh][kt][2], sc[hh][kt][3])));
        const bool inval = mrun[hh] < -1e29f;
        if (__any(lm > (inval ? -1e29f : 20.f))) {
            float mx = fmaxf(lm, __shfl_xor(lm, 16)); mx = fmaxf(mx, __shfl_xor(mx, 32));
            float d = 0.f, alpha = 1.f;
            if (mx > -1e29f) { d = inval ? mx : fmaxf(mx, 0.f); alpha = inval ? 1.f : __builtin_amdgcn_exp2f(-d); mrun[hh] = inval ? mx : mrun[hh] + d; }
#pragma unroll
            for (int kt = 0; kt < 4; ++kt) sc[hh][kt] = sc[hh][kt] - d;
            lrun[hh] *= alpha;
#pragma unroll
            for (int dt = 0; dt < 4; ++dt) O[hh][dt] = O[hh][dt] * alpha;
        }
        float rs = 0.f;
#pragma unroll
        for (int kt = 0; kt < 4; ++kt)
#pragma unroll
            for (int r = 0; r < 4; ++r) { const float p = __builtin_amdgcn_exp2f(sc[hh][kt][r]); sc[hh][kt][r] = p; rs += p; }
        lrun[hh] += rs;
#pragma unroll
        for (int kc = 0; kc < 2; ++kc) { u32x4 w; w.x = cvt_pk_bf16(sc[hh][2 * kc][0], sc[hh][2 * kc][1]); w.y = cvt_pk_bf16(sc[hh][2 * kc][2], sc[hh][2 * kc][3]);
            w.z = cvt_pk_bf16(sc[hh][2 * kc + 1][0], sc[hh][2 * kc + 1][1]); w.w = cvt_pk_bf16(sc[hh][2 * kc + 1][2], sc[hh][2 * kc + 1][3]); pf[hh][kc] = as_bf16x8(w); }
    }
#pragma unroll
    for (int dt = 0; dt < 4; ++dt)
#pragma unroll
        for (int kc = 0; kc < 2; ++kc) {
            const u32x2 va = *(const LAS u32x2*)(lds + vb_ + dt * 2304 + kc * 64);
            const u32x2 vb = *(const LAS u32x2*)(lds + vb_ + dt * 2304 + kc * 64 + 32);
            const bf16x8 vf = as_bf16x8((u32x4){va.x, va.y, vb.x, vb.y});
#pragma unroll
            for (int hh = 0; hh < 2; ++hh) O[hh][dt] = __builtin_amdgcn_mfma_f32_16x16x32_bf16(vf, pf[hh][kc], O[hh][dt], 0, 0, 0);
        }
}

DEV void attn_item(LAS unsigned char* lds, const bf16_t* P, const bf16_t* QB, const bf16_t* KV, const bf16_t* KC, const bf16_t* VC, const float* rel_bias, bf16_t* OB, int b, int g, int qt) {
    int tid = threadIdx.x; OPQV(tid);
    const int lane = tid & 63, wave = tid >> 6, fr = lane & 15, g4 = lane >> 4;
    const int qs = wave >> 1, hp = wave & 1;
    const int tl = qt * 64 + qs * 16 + fr;
    const size_t tok = (size_t)b * S_ + tl;
    unsigned kb = AT_KS + (fr * 72 + g4 * 8) * 2, vb1 = AT_VT + (fr * 72 + g4 * 4) * 2, vb2 = AT_VT + (fr * 136 + g4 * 4) * 2, btb = AT_BT + hp * 1032;
    OPQV(kb); OPQV(vb1); OPQV(vb2); OPQV(btb);
    LAS float* BT = (LAS float*)(lds + AT_BT);
    const LAS int* BK = (const LAS int*)(lds + AT_BK);
    LAS float* IA = (LAS float*)(lds + AT_IMP);
    LAS float* IB = (LAS float*)(lds + AT_IMP + 16384);
    LAS unsigned* MASK = (LAS unsigned*)(lds + AT_MASK);

    bf16x8 qf[2][2];
#pragma unroll
    for (int hh = 0; hh < 2; ++hh)
#pragma unroll
        for (int ks = 0; ks < 2; ++ks) { float qv[8]; unpack8(*(const u32x4*)(QB + tok * 1024 + (g * 4 + hp * 2 + hh) * 64 + ks * 32 + g4 * 8), qv);
#pragma unroll
            for (int e = 0; e < 8; ++e) qv[e] *= QSC_;
            qf[hh][ks] = as_bf16x8(pack8(qv)); }
    float gate[3][2];
#pragma unroll
    for (int br = 0; br < 3; ++br)
#pragma unroll
        for (int hh = 0; hh < 2; ++hh) gate[br][hh] = bf2f(P[tok * NP + COL_GN + br * 16 + g * 4 + hp * 2 + hh]);
    f32x4 F[2][4];
#pragma unroll
    for (int hh = 0; hh < 2; ++hh)
#pragma unroll
        for (int dt = 0; dt < 4; ++dt) F[hh][dt] = (f32x4){0.f, 0.f, 0.f, 0.f};

    const bf16_t* pbg = KV + (size_t)(b * 4 + g) * S_ * 64;
    KVRegs pre = kv_fetch(pbg + 2 * KV_TENSOR, pbg + 3 * KV_TENSOR, tid);
    {
        const bf16_t* kc = KC + (size_t)(b * 4 + g) * 128 * 64; const bf16_t* vc = VC + (size_t)(b * 4 + g) * 128 * 64;
#pragma unroll
        for (int it = 0; it < 2; ++it) { const int idx = it * 512 + tid, key = idx >> 3, c8 = (idx & 7) * 8;
            const u32x4 kv = *(const u32x4*)(kc + key * 64 + c8); const u32x4 vv = *(const u32x4*)(vc + key * 64 + c8);
            unsigned kw = AT_KS + (key * 72 + c8) * 2, vw = AT_VT + (c8 * 136 + key) * 2; OPQV(kw); OPQV(vw);
            *(LAS u32x4*)(lds + kw) = kv;
#pragma unroll
            for (int j = 0; j < 4; ++j) { *(LAS bf16_t*)(lds + vw + j * 544) = (bf16_t)(vv[j] & 0xffffu); *(LAS bf16_t*)(lds + vw + j * 544 + 272) = (bf16_t)(vv[j] >> 16); } }
        for (int e = tid; e < 4 * 129; e += 512) { const int r = e / 129, idx = e - r * 129; BT[e] = LOG2E_ * *(const LAS float*)(lds + AT_RB + (BK[idx] * 16 + g * 4 + r) * 4); }
    }
    __syncthreads();
    {
        const int nkt = min(8, (4 * qt + 2) / 16 + 1);
        float ia[8], ib[8];
#pragma unroll
        for (int kt = 0; kt < 8; ++kt) { ia[kt] = 0.f; ib[kt] = 0.f; }
#pragma unroll
        for (int hh = 0; hh < 2; ++hh) {
            f32x4 sc[8];
#pragma unroll
            for (int kt = 0; kt < 8; ++kt) {
                if (kt < nkt) {
                    const bf16x8 k0 = *(const LAS bf16x8*)(lds + kb + kt * 2304);
                    const bf16x8 k1 = *(const LAS bf16x8*)(lds + kb + kt * 2304 + 64);
                    f32x4 a = (f32x4){0.f, 0.f, 0.f, 0.f};
                    a = __builtin_amdgcn_mfma_f32_16x16x32_bf16(k0, qf[hh][0], a, 0, 0, 0);
                    a = __builtin_amdgcn_mfma_f32_16x16x32_bf16(k1, qf[hh][1], a, 0, 0, 0);
#pragma unroll
                    for (int r = 0; r < 4; ++r) { const int n = kt * 16 + g4 * 4 + r; const int dist = tl - (16 * n + 31);
                        const int idx = dist < 0 ? 0 : (dist > 128 ? 128 : dist);
                        const float s = a[r] + *(const LAS float*)(lds + btb + idx * 4 + hh * 516);
                        a[r] = dist >= 0 ? s : NEG_; }
                    sc[kt] = a;
                } else sc[kt] = (f32x4){NEG_, NEG_, NEG_, NEG_};
            }
            float mx = NEG_;
#pragma unroll
            for (int kt = 0; kt < 8; ++kt)
#pragma unroll
                for (int r = 0; r < 4; ++r) mx = fmaxf(mx, sc[kt][r]);
            mx = fmaxf(mx, __shfl_xor(mx, 16)); mx = fmaxf(mx, __shfl_xor(mx, 32));
            float rs = 0.f;
#pragma unroll
            for (int kt = 0; kt < 8; ++kt)
#pragma unroll
                for (int r = 0; r < 4; ++r) { const float s = sc[kt][r]; const float p = s > -1e29f ? __builtin_amdgcn_exp2f(s - mx) : 0.f; sc[kt][r] = p; rs += p; }
            rs += __shfl_xor(rs, 16); rs += __shfl_xor(rs, 32);
            const float inv = rs > 0.f ? 1.f / rs : 0.f;
#pragma unroll
            for (int kt = 0; kt < 8; ++kt) { sc[kt] = sc[kt] * inv; ia[kt] += (sc[kt][0] + sc[kt][1]) + (sc[kt][2] + sc[kt][3]); ib[kt] += sc[kt][3]; }
            f32x4 Oc[4];
#pragma unroll
            for (int dt = 0; dt < 4; ++dt) Oc[dt] = (f32x4){0.f, 0.f, 0.f, 0.f};
#pragma unroll
            for (int kc = 0; kc < 4; ++kc) {
                if (2 * kc < nkt) {
                    u32x4 w; w.x = cvt_pk_bf16(sc[2 * kc][0], sc[2 * kc][1]); w.y = cvt_pk_bf16(sc[2 * kc][2], sc[2 * kc][3]);
                    w.z = cvt_pk_bf16(sc[2 * kc + 1][0], sc[2 * kc + 1][1]); w.w = cvt_pk_bf16(sc[2 * kc + 1][2], sc[2 * kc + 1][3]);
                    const bf16x8 pf = as_bf16x8(w);
#pragma unroll
                    for (int dt = 0; dt < 4; ++dt) {
                        const u32x2 va = *(const LAS u32x2*)(lds + vb2 + dt * 4352 + kc * 64);
                        const u32x2 vb = *(const LAS u32x2*)(lds + vb2 + dt * 4352 + kc * 64 + 32);
                        const bf16x8 vf = as_bf16x8((u32x4){va.x, va.y, vb.x, vb.y});
                        Oc[dt] = __builtin_amdgcn_mfma_f32_16x16x32_bf16(vf, pf, Oc[dt], 0, 0, 0);
                    }
                }
            }
#pragma unroll
            for (int dt = 0; dt < 4; ++dt) F[hh][dt] = F[hh][dt] + Oc[dt] * gate[0][hh];
            __builtin_amdgcn_sched_barrier(0);
        }
        unsigned iw = AT_IMP + ((hp * 64 + qs * 16 + fr) * 32 + g4) * 4; OPQV(iw);
#pragma unroll
        for (int kt = 0; kt < 8; ++kt) { *(LAS float*)(lds + iw + kt * 16) = ia[kt]; *(LAS float*)(lds + iw + kt * 16 + 16384) = ib[kt]; }
    }
    __syncthreads();
    {
        LAS float* IMPF = (LAS float*)(lds + AT_IMPF);
#pragma unroll
        for (int it = 0; it < 4; ++it) { const int e = it * 512 + tid, q = e >> 5, j = e & 31;
            float v = IA[q * 32 + j] + IA[(64 + q) * 32 + j]; if (j > 0) v += IB[q * 32 + j - 1] + IB[(64 + q) * 32 + j - 1];
            IMPF[e] = v; }
        __syncthreads();
        const int cur = qt;
        const unsigned forced = 1u | (1u << cur) | (cur > 0 ? (1u << (cur - 1)) : 0u);
        const int need = 8 - __popc(forced);
        for (int it = 0; it < 4; ++it) { const int q = wave * 8 + it * 2 + (lane >> 5), j = lane & 31;
            const float v = IMPF[q * 32 + j]; int rank = 0;
            for (int jp = 1; jp <= cur - 2; ++jp) { const float vp = IMPF[q * 32 + jp]; rank += (vp > v || (vp == v && jp < j)) ? 1 : 0; }
            const bool sel = (j >= 1) && (j <= cur - 2) && (rank < need);
            const unsigned long long bal = __ballot(sel);
            const unsigned mq = forced | (unsigned)(lane < 32 ? bal : (bal >> 32));
            if (j == 0) MASK[q] = mq; }
    }
    __syncthreads();
    const unsigned mymask = MASK[qs * 16 + fr];
    unsigned anym = MASK[lane];
#pragma unroll
    for (int o = 32; o >= 1; o >>= 1) anym |= __shfl_xor(anym, o);
    anym = __builtin_amdgcn_readfirstlane(anym);
    {
        float cbias[2]; cbias[0] = *(const LAS float*)(lds + btb + 512); cbias[1] = *(const LAS float*)(lds + btb + 512 + 516);
        float mrun[2] = {NEG_, NEG_}, lrun[2] = {0.f, 0.f}; f32x4 O[2][4];
#pragma unroll
        for (int hh = 0; hh < 2; ++hh)
#pragma unroll
            for (int dt = 0; dt < 4; ++dt) O[hh][dt] = (f32x4){0.f, 0.f, 0.f, 0.f};
        unsigned rem = anym & (qt >= 31 ? 0xffffffffu : ((2u << qt) - 1u)); rem &= ~1u;
        int mode = 1, j = 0, buf = 0;
        for (;;) {
            kv_store(lds, pre, buf, tid);
            __syncthreads();
            int mode_n = mode, j_n = 0; bool more = true;
            if (mode == 1) { if (rem != 0u) { j_n = __builtin_ctz(rem); rem &= rem - 1u; } else { mode_n = 2; j_n = max(0, qt - 8); } }
            else { j_n = j + 1; more = j_n <= qt; }
            if (more) { const bf16_t* base = pbg + (size_t)j_n * 64 * 64 + (mode_n == 1 ? 2 : 4) * KV_TENSOR; pre = kv_fetch(base, base + KV_TENSOR, tid); }
            const bool near = (j >= qt - 2) || (mode == 2 && j == qt - 8);
            attn_tile(lds, qf, tl, j * 64, mode, near, ((mymask >> j) & 1u) != 0u, cbias, kb + buf * 9216, vb1 + buf * 9216, btb, g4, mrun, lrun, O);
            if (mode_n != mode || !more) {
#pragma unroll
                for (int hh = 0; hh < 2; ++hh) { float lt = lrun[hh]; lt += __shfl_xor(lt, 16); lt += __shfl_xor(lt, 32); const float sc = lt > 0.f ? gate[mode][hh] / lt : 0.f;
#pragma unroll
                    for (int dt = 0; dt < 4; ++dt) { F[hh][dt] = F[hh][dt] + O[hh][dt] * sc; O[hh][dt] = (f32x4){0.f, 0.f, 0.f, 0.f}; }
                    mrun[hh] = NEG_; lrun[hh] = 0.f; }
            }
            if (!more) break;
            mode = mode_n; j = j_n; buf ^= 1;
        }
    }
#pragma unroll
    for (int hh = 0; hh < 2; ++hh)
#pragma unroll
        for (int dt = 0; dt < 4; ++dt) { u32x2 w; w.x = cvt_pk_bf16(F[hh][dt][0], F[hh][dt][1]); w.y = cvt_pk_bf16(F[hh][dt][2], F[hh][dt][3]);
            *(u32x2*)(OB + tok * 1024 + (g * 4 + hp * 2 + hh) * 64 + dt * 16 + g4 * 4) = w; }
}

DEV void phase_mix(LAS unsigned char* lds, const bf16_t* P, const bf16_t* QB, const bf16_t* KV, const bf16_t* KC, const bf16_t* VC, const float* rel_bias, bf16_t* OB,
                   const bf16_t* VN, const float* sgu_w, const float* sgu_b, bf16_t* OC, int* ctr) {
    int tid = threadIdx.x; OPQV(tid);
    LAS int* BK = (LAS int*)(lds + AT_BK);
    if (tid < 129) { int bk; if (tid < 16) bk = tid; else { const float lr = log2f((float)tid * (1.f / 16.f)) * (1.f / 3.f); bk = 16 + (int)(lr * 16.f); if (bk > 31) bk = 31; } BK[tid] = bk; }
    *(LAS float*)(lds + AT_RB + tid * 4) = rel_bias[tid];
    __syncthreads();
    for (;;) {
        if (tid == 0) *(LAS int*)(lds + AT_NEXT) = atomicAdd(ctr, 1);
        __syncthreads();
        const int i = *(const LAS int*)(lds + AT_NEXT);
        __syncthreads();
        if (i >= 2048) break;
        if (i < 1024) attn_item(lds, P, QB, KV, KC, VC, rel_bias, OB, (i & 31) >> 2, i & 3, 31 - (i >> 5));
        else sgu_item(lds, P, VN, sgu_w, sgu_b, OC, i - 1024);
        __syncthreads();
    }
}


#define XB_TMO      128
#define XB_XCNT(j)  (256  + 64 * (j))
#define XB_XSUB(j)  (1280 + 64 * (j))
#define XB_XGEN(j)  (2304 + 64 * (j))
#define XB_TOP      3328
#define XB_TOPGEN   3392
#define XCD_BAR_WORDS 3456
#define XB_SPIN_CAP (1u << 20)
DEV unsigned xb_ld(unsigned* p)              { return __hip_atomic_load(p, __ATOMIC_RELAXED, __HIP_MEMORY_SCOPE_AGENT); }
DEV unsigned xb_add(unsigned* p, unsigned v) { return __hip_atomic_fetch_add(p, v, __ATOMIC_RELAXED, __HIP_MEMORY_SCOPE_AGENT); }
DEV unsigned xb_xcc_id() { return (unsigned)__builtin_amdgcn_s_getreg((3 << 11) | 20) & 0xFu; }
#define XB_SPIN(cond, bar) do { unsigned _sp = 0; while (cond) { __builtin_amdgcn_s_sleep(1); \
    if ((++_sp & 255u) == 0u) { if (xb_ld(&(bar)[XB_TMO])) break; if (_sp > XB_SPIN_CAP) { atomicAdd(&(bar)[XB_TMO], 1u); break; } } } } while (0)
struct XcdBarrier { unsigned* bar; unsigned x; volatile LAS unsigned* st; };
DEV XcdBarrier xcd_barrier_post(unsigned* bar, volatile LAS unsigned* st) {
    XcdBarrier b; b.bar = bar; b.x = xb_xcc_id(); b.st = st;
    if (threadIdx.x == 0) (void)xb_add(&bar[XB_XCNT(b.x)], 1u);
    return b;
}
DEV void xcd_barrier_complete(unsigned* bar, unsigned x, unsigned& nloc, unsigned& nx) {
    const unsigned G = gridDim.x * gridDim.y * gridDim.z;
    unsigned sum, cnt, mine, sp = 0u;
    for (;;) {
        sum = 0u; cnt = 0u; mine = 0u;
#pragma unroll
        for (unsigned j = 0; j < 16; ++j) { const unsigned c = xb_ld(&bar[XB_XCNT(j)]); sum += c; cnt += (c > 0u) ? 1u : 0u; mine = (j == x) ? c : mine; }
        if (sum == G) break;
        __builtin_amdgcn_s_sleep(1);
        if ((++sp & 255u) == 0u) { if (xb_ld(&bar[XB_TMO])) break; if (sp > XB_SPIN_CAP) { atomicAdd(&bar[XB_TMO], 1u); break; } }
    }
    nloc = mine > 0u ? mine : 1u; nx = cnt > 0u ? cnt : 1u;
}
DEV void xcd_barrier(const XcdBarrier& b) {
    asm volatile("s_waitcnt vmcnt(0)" ::: "memory");
    __syncthreads();
    if (threadIdx.x == 0) {
        unsigned* bar = b.bar;
        __builtin_amdgcn_s_waitcnt(0);
        unsigned nloc = b.st[0], nx = b.st[1];
        if (nloc == 0u) { xcd_barrier_complete(bar, b.x, nloc, nx); b.st[0] = nloc; b.st[1] = nx; }
        const unsigned old = xb_add(&bar[XB_XSUB(b.x)], 1u);
        const unsigned gen = old / nloc;
        if (old + 1u == (gen + 1u) * nloc) {
            __builtin_amdgcn_fence(__ATOMIC_RELEASE, "agent");
            asm volatile("s_waitcnt vmcnt(0)" ::: "memory");
            const unsigned og = xb_add(&bar[XB_TOP], 1u);
            const unsigned tg = og / nx;
            if (og + 1u == (tg + 1u) * nx) xb_add(&bar[XB_TOPGEN], 1u);
            else XB_SPIN(xb_ld(&bar[XB_TOPGEN]) == tg, bar);
            __builtin_amdgcn_fence(__ATOMIC_ACQUIRE, "agent");
            xb_add(&bar[XB_XGEN(b.x)], 1u);
            asm volatile("s_waitcnt vmcnt(0)" ::: "memory");
        } else {
            XB_SPIN(xb_ld(&bar[XB_XGEN(b.x)]) == gen, bar);
            __builtin_amdgcn_fence(__ATOMIC_ACQUIRE, "agent");
            asm volatile("s_waitcnt vmcnt(0)" ::: "memory");
        }
    }
    __syncthreads();
}

typedef const __attribute__((address_space(4))) Params* KParams;
__global__ void __launch_bounds__(512, 2) fwd_mega(Params p_unused) {
    extern __shared__ __attribute__((aligned(16))) unsigned char lds_raw[];
    LAS unsigned char* lds = (LAS unsigned char*)lds_raw;
    { volatile LAS unsigned* st = (volatile LAS unsigned*)(lds + 131072); if (threadIdx.x < 4) st[threadIdx.x] = 0u; }
    __syncthreads();
    KParams kp0 = (KParams)__builtin_amdgcn_kernarg_segment_ptr();
    XcdBarrier xbar = xcd_barrier_post((unsigned*)(kp0->ws + WS_BAR), (volatile LAS unsigned*)(lds + 131072));
    const int ph_lo = kp0->ph_lo, ph_hi = kp0->ph_hi;

    for (int ph = ph_lo; ph < ph_hi; ++ph) {
        KParams kp = (KParams)__builtin_amdgcn_kernarg_segment_ptr(); OPQS(kp);
        struct { KParams k; DEV const float* operator[](int i) const { return k->in[i]; } } pin{kp};
        unsigned char* ws = kp->ws;
        bf16_t* WIN = (bf16_t*)(ws + WS_WIN); bf16_t* WBR = (bf16_t*)(ws + WS_WBR); bf16_t* WO = (bf16_t*)(ws + WS_WO); bf16_t* WUP = (bf16_t*)(ws + WS_WUP);
        bf16_t* WDN = (bf16_t*)(ws + WS_WDN); bf16_t* W1T = (bf16_t*)(ws + WS_W1T); bf16_t* W2T = (bf16_t*)(ws + WS_W2T);
        bf16_t* KC = (bf16_t*)(ws + WS_KC); bf16_t* VC = (bf16_t*)(ws + WS_VC); bf16_t* H = (bf16_t*)(ws + WS_H); bf16_t* P = (bf16_t*)(ws + WS_P);
        bf16_t* O3 = (bf16_t*)(ws + WS_O3);
        bf16_t* OA = O3; bf16_t* OB = O3 + (size_t)T_ * 1024; bf16_t* OC = O3 + (size_t)2 * T_ * 1024;
        bf16_t* X = (bf16_t*)(ws + WS_X); float* OUT = kp->out;
        const int G = gridDim.x, c = blockIdx.x;
        if (ph == NPHASE - 1) {
            if (PHON(10)) phase_rmsnorm(nullptr, X, pin[20], nullptr, nullptr, OUT);
        } else {
            const int l = ph / 10, k = ph % 10;
            if (k == 0) { if (PHON(0)) {
                if (l == 0 && blockIdx.x == 0 && threadIdx.x < 4) ((int*)(ws + WS_MF))[threadIdx.x * 64] = 0;
                convT<128>(lds, pin[3] + (size_t)l * 1024 * NIN, 1024, NIN, WIN, NP, 1, 0);
                convT<128>(lds, pin[12] + (size_t)l * 1024 * 1024, 1024, 1024, WBR, 1024, 0, 192);
                convT<128>(lds, pin[13] + (size_t)l * 1024 * 1024, 1024, 1024, WBR + (size_t)1024 * 1024, 1024, 0, 192);
                convT<128>(lds, pin[14] + (size_t)l * 1024 * 1024, 1024, 1024, WBR + (size_t)2048 * 1024, 1024, 0, 192);
                convT<128>(lds, pin[15] + (size_t)l * 1024 * 1024, 1024, 1024, WO, 1024, 0, 192);
                convT<128>(lds, pin[17] + (size_t)l * 1024 * 6144, 1024, 6144, WUP, 6144, 2, 192);
                convT<128>(lds, pin[19] + (size_t)l * 3072 * 1024, 3072, 1024, WDN, 1024, 0, 192);
                convT<128>(lds, pin[6] + (size_t)(l * 2 + 0) * 2048 * 128, 2048, 128, W1T, 128, 0, 0);
                convT<128>(lds, pin[6] + (size_t)(l * 2 + 1) * 2048 * 128, 2048, 128, W1T + (size_t)128 * 2048, 128, 0, 64);
                convT<64>(lds, pin[7] + (size_t)(l * 2 + 0) * 128 * 64, 128, 64, W2T, 64, 0, 128);
                convT<64>(lds, pin[7] + (size_t)(l * 2 + 1) * 128 * 64, 128, 64, W2T + (size_t)64 * 128, 64, 0, 130);
                phase_rmsnorm(l == 0 ? pin[0] : nullptr, X, pin[2] + l * 1024, H, l == 0 ? X : nullptr, nullptr); }
            } else if (k == 1) { if (PHON(1)) {
                pg8::Gemm g{H, WIN, T_, NP, 1024}; pg8::StaticOrder S; S.init(T_, NP, G, c); pg8::EpiProj E{P, NP, 0, (bf16_t*)(ws + WS_KV), OA, (bf16_t*)(ws + WS_QB), pin[4] + (size_t)l * 3 * 1024, (float*)(ws + WS_GLA), (float*)(ws + WS_GFA), lds + LDS_EX};
                pg8::gemm_phase<true>(lds, g, S, E); }
            } else if (k == 2) { if (PHON(2)) {
                phase_compress(lds, (const bf16_t*)(ws + WS_KV), pin[5] + (size_t)l * 2 * 2048, W1T, W2T, KC, VC);
                phase_rowpass(P, pin[4] + (size_t)l * 3 * 1024, pin[10] + l * 1024, pin[11] + l * 1024, OA, H  , (const float*)(ws + WS_GLA), (const float*)(ws + WS_GFA)); }
            } else if (k == 3) { if (PHON(3)) {
                if (PHON(11)) phase_mix(lds, P, (const bf16_t*)(ws + WS_QB), (const bf16_t*)(ws + WS_KV), KC, VC, pin[1], OB, H  , pin[8] + (size_t)l * 8 * 128 * 128, pin[9] + (size_t)l * 8 * 128, OC, (int*)(ws + WS_MF) + l * 64); }
            } else if (k == 4) { if (PHON(4)) {
                pg8::Gemm g{O3, WBR, 3 * T_, 3072, 1024}; pg8::BranchOrder S; S.init(G, c); pg8::EpiBranch E{P, H  };
                pg8::gemm_phase<true>(lds, g, S, E); }
            } else if (k == 5) { if (PHON(5)) {
                pg8::Gemm g{H  , WO, T_, 1024, 1024}; pg8::StaticOrder S; S.init(T_, 1024, G, c); pg8::EpiRes E{X};
                pg8::gemm_phase<false>(lds, g, S, E); }
            } else if (k == 6) { if (PHON(6)) {
                phase_rmsnorm(nullptr, X, pin[16] + l * 1024, H, nullptr, nullptr); }
            } else if (k == 7) { if (PHON(7)) {
                pg8::Gemm g{H, WUP, T_, 6144, 1024}; pg8::StaticOrder S; S.init(T_, 6144, G, c);
                pg8::EpiAct E{O3  , pin[18] + (size_t)l * 3 * DFF, (float*)(ws + WS_GL), (float*)(ws + WS_GF), lds + LDS_EX};
                pg8::gemm_phase<true>(lds, g, S, E); }
            } else if (k == 8) {
                continue;
            } else { if (PHON(9)) {
                pg8::Gemm g{O3  , WDN, T_, 1024, 3072}; pg8::StaticOrder S; S.init(T_, 1024, G, c); pg8::EpiRes E{X};
                for (int i = 0;; ++i) { pg8::Unit uu; if (!S.next(i, uu)) break;
                    phase_actfix((const float*)(ws + WS_GL), (const float*)(ws + WS_GF), pin[18] + (size_t)l * 3 * DFF, O3  , uu.pm, 1); }
                asm volatile("s_waitcnt vmcnt(0)" ::: "memory"); __syncthreads();
                pg8::gemm_phase<false>(lds, g, S, E); }
            }
        }
        if (ph + 1 < ph_hi) { if (ph == ph_lo) cg::this_grid().sync(); else xcd_barrier(xbar); }
    }
}

extern "C" void kernel_launch(void* const* d_in, const int* in_sizes, int n_in, void* d_out, int out_size, void* d_ws, size_t ws_size, hipStream_t stream) {
    static int grid = 0;
    if (grid == 0) {
        if (n_in != 21 || out_size != T_ * 1024 || ws_size < WS_END) { fprintf(stderr, "kernel_launch: unexpected shapes (n_in %d out %d ws %zu need %zu)\n", n_in, out_size, ws_size, (size_t)WS_END); grid = -1; return; }
        int dev = 0, cus = 0, per_cu = 0;
        hipGetDevice(&dev); hipDeviceGetAttribute(&cus, hipDeviceAttributeMultiprocessorCount, dev);
        hipFuncSetAttribute((const void*)fwd_mega, hipFuncAttributeMaxDynamicSharedMemorySize, LDS_BYTES);
        hipOccupancyMaxActiveBlocksPerMultiprocessor(&per_cu, (const void*)fwd_mega, 512, LDS_BYTES);
        if (per_cu < 1) { fprintf(stderr, "kernel_launch: occupancy query says %d blocks per CU\n", per_cu); per_cu = 1; }
        (void)hipGetLastError();
        grid = cus;
    }
    if (grid < 0) return;
    if (hipMemsetAsync((char*)d_ws + WS_BAR, 0, XCD_BAR_WORDS * 4, stream) != hipSuccess) { fprintf(stderr, "kernel_launch: memset of the barrier words failed\n"); return; }
    Params p{};
    for (int i = 0; i < 21; ++i) p.in[i] = (const float*)d_in[i];
    p.out = (float*)d_out; p.ws = (unsigned char*)d_ws;
#if PER_PHASE_LAUNCH
    for (int ph = 0; ph < NPHASE; ++ph) { p.ph_lo = ph; p.ph_hi = ph + 1; hipLaunchKernelGGL(fwd_mega, dim3(grid), dim3(512), LDS_BYTES, stream, p); }
#else
    p.ph_lo = 0; p.ph_hi = NPHASE;
    void* args[] = {&p};
    hipError_t e = hipLaunchCooperativeKernel((const void*)fwd_mega, dim3(grid), dim3(512), args, LDS_BYTES, stream);
    if (e != hipSuccess) fprintf(stderr, "cooperative launch failed: %s (grid %d)\n", hipGetErrorString(e), grid);
#endif
}
```
